# Optimizing an MI355X kernel written in HIP

```python
import jax, jax.numpy as jnp
from jax import lax
import numpy as np

D_MODEL = 1024
BATCH = 32
SEQ = 2048
DEPTH = 4
DEC_BATCH = 16
DEC_SEQ = 16
PAST_LEN = 2048

CHUNK = 64
Q_BLOCK = 128
N_HEADS = 8
QK_NOPE_DIM = 64
QK_ROPE_DIM = 32
V_HEAD_DIM = 64
Q_LORA = 384
KV_LORA = 256
ROPE_THETA = 10000.0
ATTN_SCALE = (QK_NOPE_DIM + QK_ROPE_DIM) ** -0.5
CONF_CH = 256
CONF_WIDTH = 31
SC_CH = 256
SC_WIDTH = 3
N_BRANCH = 3
D_FF = 4 * D_MODEL
DN_ALPHA = (2 * DEPTH) ** 0.25
DN_BETA = (8 * DEPTH) ** -0.25
LN_EPS = 1e-5
RMS_EPS = 1e-6
SPLITS = (Q_LORA, KV_LORA, QK_ROPE_DIM, 2 * CONF_CH, 3 * SC_CH, N_BRANCH * D_MODEL)
N_IN = Q_LORA + KV_LORA + QK_ROPE_DIM + 2 * CONF_CH + 3 * SC_CH + N_BRANCH * D_MODEL

kernel_name = "mla_conformer_shortconv_deepnorm_step"


def layer_norm(x, g, b):
    xf = x.astype(jnp.float32)
    mu = xf.mean(-1, keepdims=True)
    var = jnp.square(xf - mu).mean(-1, keepdims=True)
    return ((xf - mu) * lax.rsqrt(var + LN_EPS) * g.astype(jnp.float32) + b.astype(jnp.float32)).astype(x.dtype)


def rms_norm(x, g):
    xf = x.astype(jnp.float32)
    ms = jnp.square(xf).mean(-1, keepdims=True)
    return (xf * lax.rsqrt(ms + RMS_EPS) * g.astype(jnp.float32)).astype(x.dtype)


def rope(x, pos):
    half = QK_ROPE_DIM // 2
    inv = ROPE_THETA ** (-jnp.arange(half, dtype=jnp.float32) / half)
    ang = pos.astype(jnp.float32)[:, None] * inv[None, :]
    cos = jnp.cos(ang)[None, :, None, :]
    sin = jnp.sin(ang)[None, :, None, :]
    xf = x.astype(jnp.float32)
    x1, x2 = xf[..., :half], xf[..., half:]
    return jnp.concatenate([x1 * cos - x2 * sin, x1 * sin + x2 * cos], axis=-1).astype(x.dtype)


def depthwise_conv(xp, w):
    c = xp.shape[-1]
    return lax.conv_general_dilated(xp, w[:, None, :].astype(xp.dtype), window_strides=(1,), padding='VALID',
                                    dimension_numbers=('NWC', 'WIO', 'NWC'), feature_group_count=c)


def mla_block(q_nope, q_rope, q_pos, ckv, krope, k_pos, w_uk, w_uv):
    q_lat = jnp.einsum('bqhd,chd->bqhc', q_nope, w_uk)
    s = jnp.einsum('bqhc,bkc->bhqk', q_lat, ckv) + jnp.einsum('bqhr,bkr->bhqk', q_rope, krope)
    s = s.astype(jnp.float32) * ATTN_SCALE
    mask = (k_pos[None, :] // CHUNK) <= (q_pos[:, None] // CHUNK)
    s = jnp.where(mask[None, None], s, -1e30)
    p = jax.nn.softmax(s, axis=-1).astype(ckv.dtype)
    o_lat = jnp.einsum('bhqk,bkc->bqhc', p, ckv)
    return jnp.einsum('bqhc,chd->bqhd', o_lat, w_uv)


def mla_attention(q_nope, q_rope, q_pos, ckv, krope, k_pos, w_uk, w_uv):
    b, l = q_nope.shape[:2]
    if l > Q_BLOCK and l % Q_BLOCK == 0:
        nb = l // Q_BLOCK

        def blk(a):
            return a.reshape((b, nb, Q_BLOCK) + a.shape[2:]).swapaxes(0, 1)

        out = lax.map(lambda t: mla_block(t[0], t[1], t[2], ckv, krope, k_pos, w_uk, w_uv),
                      (blk(q_nope), blk(q_rope), q_pos.reshape(nb, Q_BLOCK)))
        return out.swapaxes(0, 1).reshape(b, l, N_HEADS, V_HEAD_DIM)
    return mla_block(q_nope, q_rope, q_pos, ckv, krope, k_pos, w_uk, w_uv)


def trunk_layer(x, past_ckv, past_krope, past_conf, past_sc, p):
    (w_in, b_gate, q_norm_g, w_uq, kv_norm_g, w_uk, w_uv, w_mla_out, conf_dw_w, conf_dw_b, conf_ln_g, conf_ln_b,
     w_conf_out, sc_dw_w, w_sc_out, w_mix_out, ln1_g, ln1_b, w_ff1, b_ff1, w_ff2, b_ff2, ln2_g, ln2_b) = p
    b, l, _ = x.shape
    past = past_ckv.shape[1]
    proj = x @ w_in
    offs = [int(o) for o in np.cumsum(SPLITS)[:-1]]
    q_c, kv_c, k_r, conf_in, sc_in, gate_in = jnp.split(proj, offs, axis=-1)
    pos = past + jnp.arange(l)

    q = jnp.einsum('blc,chd->blhd', rms_norm(q_c, q_norm_g), w_uq)
    q_nope = q[..., :QK_NOPE_DIM]
    q_rope = rope(q[..., QK_NOPE_DIM:], pos)
    c_kv = rms_norm(kv_c, kv_norm_g)
    k_rope = rope(k_r[:, :, None, :], pos)[:, :, 0]
    keys_ckv = jnp.concatenate([past_ckv, c_kv], axis=1)
    keys_kr = jnp.concatenate([past_krope, k_rope], axis=1)
    k_pos = jnp.arange(past + l)
    o = mla_attention(q_nope, q_rope, pos, keys_ckv, keys_kr, k_pos, w_uk, w_uv)
    mla_out = o.reshape(b, l, N_HEADS * V_HEAD_DIM) @ w_mla_out

    ca, cg = jnp.split(conf_in, 2, axis=-1)
    u = ca * jax.nn.sigmoid(cg)
    up = jnp.concatenate([past_conf, u], axis=1)
    new_conf = up[:, -(CONF_WIDTH - 1):]
    cv = depthwise_conv(up, conf_dw_w) + conf_dw_b
    conf_out = jax.nn.silu(layer_norm(cv, conf_ln_g, conf_ln_b)) @ w_conf_out

    gb, gc, h = jnp.split(sc_in, 3, axis=-1)
    z = gc * h
    zp = jnp.concatenate([past_sc, z], axis=1)
    new_sc = zp[:, -(SC_WIDTH - 1):]
    sc_out = (gb * depthwise_conv(zp, sc_dw_w)) @ w_sc_out

    g = jax.nn.sigmoid(gate_in.reshape(b, l, N_BRANCH, D_MODEL) + b_gate)
    merged = g[:, :, 0] * mla_out + g[:, :, 1] * conf_out + g[:, :, 2] * sc_out
    x = layer_norm(DN_ALPHA * x + merged @ w_mix_out, ln1_g, ln1_b)

    hdn = jnp.square(jax.nn.relu(x @ w_ff1 + b_ff1))
    x = layer_norm(DN_ALPHA * x + (hdn @ w_ff2 + b_ff2), ln2_g, ln2_b)
    return x, c_kv, k_rope, new_conf, new_sc


def setup_inputs(seed: int = 0) -> dict:
    key = jax.random.key(seed)
    ks = jax.random.split(key, 32)
    f32 = jnp.float32

    def nrm(k, shape, scale):
        return jax.random.normal(k, shape, f32) * scale

    return {
        "x_prompt": nrm(ks[0], (BATCH, SEQ, D_MODEL), 1.0),
        "x_sample": nrm(ks[1], (DEC_BATCH, DEC_SEQ, D_MODEL), 1.0),
        "cache_ckv": nrm(ks[2], (DEPTH, DEC_BATCH, PAST_LEN, KV_LORA), 1.0),
        "cache_krope": nrm(ks[3], (DEPTH, DEC_BATCH, PAST_LEN, QK_ROPE_DIM), 1.0),
        "state_conf": nrm(ks[4], (DEPTH, DEC_BATCH, CONF_WIDTH - 1, CONF_CH), 0.5),
        "state_sc": nrm(ks[5], (DEPTH, DEC_BATCH, SC_WIDTH - 1, SC_CH), 0.5),
        "w_in": nrm(ks[6], (DEPTH, D_MODEL, N_IN), D_MODEL ** -0.5),
        "b_gate": nrm(ks[7], (DEPTH, N_BRANCH, D_MODEL), 0.02),
        "q_norm_g": 1.0 + nrm(ks[8], (DEPTH, Q_LORA), 0.02),
        "w_uq": nrm(ks[9], (DEPTH, Q_LORA, N_HEADS, QK_NOPE_DIM + QK_ROPE_DIM), Q_LORA ** -0.5),
        "kv_norm_g": 1.0 + nrm(ks[10], (DEPTH, KV_LORA), 0.02),
        "w_uk": nrm(ks[11], (DEPTH, KV_LORA, N_HEADS, QK_NOPE_DIM), KV_LORA ** -0.5),
        "w_uv": nrm(ks[12], (DEPTH, KV_LORA, N_HEADS, V_HEAD_DIM), DN_BETA * KV_LORA ** -0.5),
        "w_mla_out": nrm(ks[13], (DEPTH, N_HEADS * V_HEAD_DIM, D_MODEL), (N_HEADS * V_HEAD_DIM) ** -0.5),
        "conf_dw_w": nrm(ks[14], (DEPTH, CONF_WIDTH, CONF_CH), CONF_WIDTH ** -0.5),
        "conf_dw_b": nrm(ks[15], (DEPTH, CONF_CH), 0.02),
        "conf_ln_g": 1.0 + nrm(ks[16], (DEPTH, CONF_CH), 0.02),
        "conf_ln_b": nrm(ks[17], (DEPTH, CONF_CH), 0.02),
        "w_conf_out": nrm(ks[18], (DEPTH, CONF_CH, D_MODEL), CONF_CH ** -0.5),
        "sc_dw_w": nrm(ks[19], (DEPTH, SC_WIDTH, SC_CH), SC_WIDTH ** -0.5),
        "w_sc_out": nrm(ks[20], (DEPTH, SC_CH, D_MODEL), SC_CH ** -0.5),
        "w_mix_out": nrm(ks[21], (DEPTH, D_MODEL, D_MODEL), DN_BETA * D_MODEL ** -0.5),
        "ln1_g": 1.0 + nrm(ks[22], (DEPTH, D_MODEL), 0.02),
        "ln1_b": nrm(ks[23], (DEPTH, D_MODEL), 0.02),
        "w_ff1": nrm(ks[24], (DEPTH, D_MODEL, D_FF), DN_BETA * D_MODEL ** -0.5),
        "b_ff1": nrm(ks[25], (DEPTH, D_FF), 0.02),
        "w_ff2": nrm(ks[26], (DEPTH, D_FF, D_MODEL), DN_BETA * D_FF ** -0.5),
        "b_ff2": nrm(ks[27], (DEPTH, D_MODEL), 0.02),
        "ln2_g": 1.0 + nrm(ks[28], (DEPTH, D_MODEL), 0.02),
        "ln2_b": nrm(ks[29], (DEPTH, D_MODEL), 0.02),
    }


def reference(x_prompt, x_sample, cache_ckv, cache_krope, state_conf, state_sc, w_in, b_gate, q_norm_g, w_uq,
              kv_norm_g, w_uk, w_uv, w_mla_out, conf_dw_w, conf_dw_b, conf_ln_g, conf_ln_b, w_conf_out, sc_dw_w,
              w_sc_out, w_mix_out, ln1_g, ln1_b, w_ff1, b_ff1, w_ff2, b_ff2, ln2_g, ln2_b):
    def layer_params(i):
        return (w_in[i], b_gate[i], q_norm_g[i], w_uq[i], kv_norm_g[i], w_uk[i], w_uv[i], w_mla_out[i],
                conf_dw_w[i], conf_dw_b[i], conf_ln_g[i], conf_ln_b[i], w_conf_out[i], sc_dw_w[i], w_sc_out[i],
                w_mix_out[i], ln1_g[i], ln1_b[i], w_ff1[i], b_ff1[i], w_ff2[i], b_ff2[i], ln2_g[i], ln2_b[i])

    def run(x, past_ckv, past_krope, past_conf, past_sc):
        ckvs, krs, confs, scs = [], [], [], []
        for i in range(DEPTH):
            x, c_kv, k_rope, n_conf, n_sc = trunk_layer(x, past_ckv[i], past_krope[i], past_conf[i], past_sc[i],
                                                         layer_params(i))
            ckvs.append(c_kv)
            krs.append(k_rope)
            confs.append(n_conf)
            scs.append(n_sc)
        return x, jnp.stack(ckvs), jnp.stack(krs), jnp.stack(confs), jnp.stack(scs)

    bp = x_prompt.shape[0]
    dt = x_prompt.dtype
    y_prompt, ckv_p, kr_p, conf_p, sc_p = run(
        x_prompt,
        jnp.zeros((DEPTH, bp, 0, KV_LORA), dt),
        jnp.zeros((DEPTH, bp, 0, QK_ROPE_DIM), dt),
        jnp.zeros((DEPTH, bp, CONF_WIDTH - 1, CONF_CH), dt),
        jnp.zeros((DEPTH, bp, SC_WIDTH - 1, SC_CH), dt))
    y_sample, ckv_s, kr_s, conf_s, sc_s = run(x_sample, cache_ckv, cache_krope, state_conf, state_sc)
    return (y_prompt, y_sample, ckv_p, kr_p, conf_p, sc_p, ckv_s, kr_s, conf_s, sc_s)
```

```cpp
#define USE_SIMPLE 0
#define GEMM_ALIGN true
#define GEMM_SP2 true
#include <hip/hip_runtime.h>
#include <hip/hip_cooperative_groups.h>
#include <cstdio>
#include <cmath>
#include <cstring>
namespace cg = cooperative_groups;
namespace pg8 {
#define PG8_LAS __attribute__((address_space(3)))
typedef unsigned short bf16_t;
typedef short bf16x8 __attribute__((ext_vector_type(8)));
typedef float f32x4 __attribute__((ext_vector_type(4)));
typedef unsigned u32x4 __attribute__((ext_vector_type(4)));
constexpr int BM = 256, BK = 64, HALF = 128, HTB = HALF * BK * 2  , STAGE_BYTES = 8 * HTB, NXCD = 8, WGM = 8;

__host__ __device__ __forceinline__ int lds_byte(int r, int c) { const int st = (r >> 4) * 2 + (c >> 5), rr = r & 15, cc = c & 31, ob = rr * 64 + cc * 2; return st * 1024 + (ob ^ (((ob >> 9) & 1) << 5)); }
__host__ __device__ __forceinline__ void stage_rc(int b, int& R, int& C) { const int st = b / 1024, sb = b % 1024, swz = sb ^ (((sb >> 9) & 1) << 5); R = (st >> 1) * 16 + swz / 64; C = (st & 1) * 32 + (swz % 64) / 2; }
__host__ __device__ __forceinline__ int perm32(int rho) { const int n = rho >> 4, i = rho & 15; return 8 * (i >> 2) + 4 * n + (i & 3); }

struct Unit { int pm, pn; };
struct Gemm { const bf16_t* A; const bf16_t* Bt; int M, N, K; };

struct StaticOrder {
    int nM, nN, nwg, G, c;
    __host__ __device__ void init(int M, int N, int G_, int c_) { nM = M / BM; nN = N / BM; nwg = nM * nN; G = G_; c = c_; }
    __host__ __device__ bool next(int i, Unit& u) const {
        const long L = (long)i * G + c; if (L >= nwg) return false;
        int wgid = (int)L; { const int q = nwg / NXCD, r = nwg % NXCD, xcd = wgid % NXCD, off = wgid / NXCD; wgid = (xcd < r ? xcd * (q + 1) : r * (q + 1) + (xcd - r) * q) + off; }
        const int nig = WGM * nN, gid = wgid / nig, fm = gid * WGM, gsz = (nM - fm) < WGM ? (nM - fm) : WGM;
        u.pm = fm + ((wgid % nig) % gsz); u.pn = (wgid % nig) / gsz; return true;
    }
    __device__ __forceinline__ void a_ready(const Unit&) const {}
    __device__ __forceinline__ void done(const Unit&) const {}
};
typedef float f32x2c __attribute__((ext_vector_type(2)));
typedef __bf16 bf16x2c __attribute__((ext_vector_type(2)));
__device__ __forceinline__ unsigned cvt_pk_bf16(float lo, float hi) { const f32x2c v = {lo, hi}; const bf16x2c b = __builtin_convertvector(v, bf16x2c); return __builtin_bit_cast(unsigned, b); }
template <class Epi, class Sched, bool ALIGN_EPI = false, bool SP2 = false>
__device__ __forceinline__ void gemm_phase(PG8_LAS unsigned char* lds, int tid_in, const Gemm g, const Sched& S, const Epi& E) {
    int tid_ = tid_in; asm volatile("" : "+v"(tid_));
    const int tid = tid_, wid = __builtin_amdgcn_readfirstlane(tid >> 6), lane = tid & 63, wr = wid >> 2, wc = wid & 3, fr = lane & 15, fq = lane >> 4;
    const int K = g.K, nt = K / BK;
    unsigned voffA[2], voffB[2];
#pragma unroll
    for (int i = 0; i < 2; ++i) { int R, C; stage_rc(tid * 16 + i * 8192, R, C); const int Rb = Epi::PERM ? ((R & ~31) + perm32(R & 31)) : R;
        voffA[i] = (unsigned)(R * K + C) * 2u; voffB[i] = (unsigned)(Rb * K + C) * 2u; }
    const size_t kstep = (size_t)(BK * 2);
    const size_t hstep = (size_t)HALF * K * 2;
    const size_t tstep = 2 * hstep;
    const unsigned ldsw = (unsigned)wid * 1024u;
    const int aoff = lds_byte(wr * 64 + fr, fq * 8), boff = lds_byte(wc * 32 + fr, fq * 8);
#define PG8_SA(b, h) (((b) * 2 + (h)) * HTB)
#define PG8_SB(b, h) ((4 + (b) * 2 + (h)) * HTB)
#define PG8_STAGE(bufoff, gbase, voff) do { _Pragma("unroll") for (int _i = 0; _i < 2; ++_i) \
        __builtin_amdgcn_global_load_lds((const unsigned*)((const char*)(gbase) + (voff)[_i]), (PG8_LAS unsigned*)(lds + (bufoff) + ldsw + _i * 8192), 16, 0, 0); } while (0)
#define PG8_LDA(dst, b, h) do { _Pragma("unroll") for (int m = 0; m < 4; ++m) _Pragma("unroll") for (int k = 0; k < 2; ++k) dst[m][k] = *(const PG8_LAS bf16x8*)(lds + PG8_SA(b, h) + aoff + m * 2048 + k * 1024); } while (0)
#define PG8_LDB(dst, b, h) do { _Pragma("unroll") for (int n = 0; n < 2; ++n) _Pragma("unroll") for (int k = 0; k < 2; ++k) dst[n][k] = *(const PG8_LAS bf16x8*)(lds + PG8_SB(b, h) + boff + n * 2048 + k * 1024); } while (0)
#define PG8_MMA(ai, bj, At, Bt) do { __builtin_amdgcn_s_setprio(1); _Pragma("unroll") for (int m = 0; m < 4; ++m) _Pragma("unroll") for (int n = 0; n < 2; ++n) _Pragma("unroll") for (int k = 0; k < 2; ++k) \
        acc[ai][bj][m][n] = __builtin_amdgcn_mfma_f32_16x16x32_bf16(Bt[n][k], At[m][k], acc[ai][bj][m][n], 0, 0, 0); __builtin_amdgcn_s_setprio(0); } while (0)
#define PG8_WAIT_V(n) asm volatile("s_waitcnt vmcnt(" #n ")" ::: "memory")
#define PG8_WAIT_L(n) asm volatile("s_waitcnt lgkmcnt(" #n ")" ::: "memory")
#define PG8_BAR __builtin_amdgcn_s_barrier()
#define PG8_SCHED __builtin_amdgcn_sched_barrier(0)
    Unit cur, nxt; int ui = 0;
    if (!S.next(0, cur)) return;
    f32x4 acc[2][2][4][2];
#pragma unroll
    for (int a = 0; a < 2; ++a)
#pragma unroll
        for (int b = 0; b < 2; ++b)
#pragma unroll
            for (int m = 0; m < 4; ++m)
#pragma unroll
                for (int n = 0; n < 2; ++n) acc[a][b][m][n] = (f32x4){0.f, 0.f, 0.f, 0.f};
    bf16x8 At[4][2], B0[2][2], B1[2][2];
    const char* cA = (const char*)g.A + (size_t)cur.pm * tstep; const char* cB = (const char*)g.Bt + (size_t)cur.pn * tstep;
    S.a_ready(cur);
    if constexpr (SP2) {
        PG8_STAGE(PG8_SB(0, 0), cB, voffB); PG8_STAGE(PG8_SB(0, 1), cB + hstep, voffB); PG8_STAGE(PG8_SA(0, 0), cA, voffA); PG8_STAGE(PG8_SA(0, 1), cA + hstep, voffA);
        if (wr == 1) PG8_BAR;
        PG8_WAIT_V(2); PG8_BAR;
        PG8_STAGE(PG8_SB(1, 0), cB + kstep, voffB); PG8_STAGE(PG8_SA(1, 0), cA + kstep, voffA); PG8_STAGE(PG8_SB(1, 1), cB + hstep + kstep, voffB);
        PG8_WAIT_V(6); PG8_BAR;
    } else {
        PG8_STAGE(PG8_SB(0, 0), cB, voffB); PG8_STAGE(PG8_SA(0, 0), cA, voffA); PG8_STAGE(PG8_SB(0, 1), cB + hstep, voffB); PG8_STAGE(PG8_SA(0, 1), cA + hstep, voffA);
        if (wr == 1) PG8_BAR;
        PG8_WAIT_V(4); PG8_BAR;
        PG8_STAGE(PG8_SB(1, 0), cB + kstep, voffB); PG8_STAGE(PG8_SA(1, 0), cA + kstep, voffA); PG8_STAGE(PG8_SB(1, 1), cB + hstep + kstep, voffB);
        PG8_WAIT_V(6); PG8_BAR;
    }
    for (;;) {
        const bool has_next = S.next(ui + 1, nxt);
        const char* nA = has_next ? (const char*)g.A + (size_t)nxt.pm * tstep : cA; const char* nB = has_next ? (const char*)g.Bt + (size_t)nxt.pn * tstep : cB;
        for (int t = 0; t < nt; t += 2) {
            const bool last = (t == nt - 2);
            const char* a1 = cA + (size_t)(t + 1) * kstep;
            const char* a2 = last ? nA : cA + (size_t)(t + 2) * kstep; const char* b2 = last ? nB : cB + (size_t)(t + 2) * kstep;
            const char* a3 = a2 + kstep; const char* b3 = b2 + kstep;
            if (last && has_next) S.a_ready(nxt);
            if constexpr (SP2) {
            PG8_LDB(B0, 0, 0); PG8_LDB(B1, 0, 1); PG8_SCHED; PG8_LDA(At, 0, 0); PG8_STAGE(PG8_SA(1, 1), a1 + hstep, voffA);
            PG8_WAIT_V(8); PG8_WAIT_L(0); PG8_BAR; PG8_MMA(0, 0, At, B0); PG8_MMA(0, 1, At, B1); PG8_BAR; PG8_SCHED;
            PG8_LDA(At, 0, 1); PG8_STAGE(PG8_SB(0, 0), b2, voffB); PG8_STAGE(PG8_SB(0, 1), b2 + hstep, voffB); PG8_STAGE(PG8_SA(0, 0), a2, voffA);
            PG8_WAIT_V(8); PG8_WAIT_L(0); PG8_BAR; PG8_MMA(1, 0, At, B0); PG8_MMA(1, 1, At, B1); PG8_BAR; PG8_SCHED;
            PG8_LDB(B0, 1, 0); PG8_LDB(B1, 1, 1); PG8_SCHED; PG8_LDA(At, 1, 0); PG8_STAGE(PG8_SA(0, 1), a2 + hstep, voffA);
            PG8_WAIT_V(8); PG8_WAIT_L(0); PG8_BAR; PG8_MMA(0, 0, At, B0); PG8_MMA(0, 1, At, B1); PG8_BAR; PG8_SCHED;
            PG8_LDA(At, 1, 1); PG8_STAGE(PG8_SB(1, 0), b3, voffB); PG8_STAGE(PG8_SB(1, 1), b3 + hstep, voffB); PG8_STAGE(PG8_SA(1, 0), a3, voffA);
            PG8_WAIT_V(8); PG8_WAIT_L(0); PG8_BAR; PG8_MMA(1, 0, At, B0); PG8_MMA(1, 1, At, B1); PG8_BAR; PG8_SCHED;
            } else {
            PG8_LDB(B0, 0, 0); PG8_SCHED; PG8_LDA(At, 0, 0); PG8_STAGE(PG8_SA(1, 1), a1 + hstep, voffA);
            PG8_WAIT_L(8); PG8_BAR; PG8_WAIT_L(0); PG8_MMA(0, 0, At, B0); PG8_BAR; PG8_SCHED;
            PG8_LDB(B1, 0, 1); PG8_STAGE(PG8_SB(0, 0), b2, voffB);
            PG8_BAR; PG8_WAIT_L(0); PG8_MMA(0, 1, At, B1); PG8_BAR;
            PG8_LDA(At, 0, 1); PG8_STAGE(PG8_SA(0, 0), a2, voffA);
            PG8_BAR; PG8_WAIT_L(0); PG8_MMA(1, 0, At, B0); PG8_BAR; PG8_SCHED;
            PG8_STAGE(PG8_SB(0, 1), b2 + hstep, voffB);
            PG8_WAIT_V(6); PG8_BAR; PG8_MMA(1, 1, At, B1); PG8_BAR;
            PG8_LDB(B0, 1, 0); PG8_SCHED; PG8_LDA(At, 1, 0); PG8_STAGE(PG8_SA(0, 1), a2 + hstep, voffA);
            PG8_WAIT_L(8); PG8_BAR; PG8_WAIT_L(0); PG8_MMA(0, 0, At, B0); PG8_BAR; PG8_SCHED;
            PG8_LDB(B1, 1, 1); PG8_STAGE(PG8_SB(1, 0), b3, voffB);
            PG8_BAR; PG8_WAIT_L(0); PG8_MMA(0, 1, At, B1); PG8_BAR;
            PG8_LDA(At, 1, 1); PG8_STAGE(PG8_SA(1, 0), a3, voffA);
            PG8_BAR; PG8_WAIT_L(0); PG8_MMA(1, 0, At, B0); PG8_BAR; PG8_SCHED;
            PG8_STAGE(PG8_SB(1, 1), b3 + hstep, voffB);
            PG8_WAIT_V(6); PG8_BAR; PG8_MMA(1, 1, At, B1); PG8_BAR;
            }
        }
        if constexpr (ALIGN_EPI) { if (wr == 0) PG8_BAR; }
        if constexpr (!Epi::AFTER_DRAIN) { E(acc, cur, wr, wc, fr, fq); S.done(cur); }
        if (!has_next) break;
#pragma unroll
        for (int a = 0; a < 2; ++a)
#pragma unroll
            for (int b = 0; b < 2; ++b)
#pragma unroll
                for (int m = 0; m < 4; ++m)
#pragma unroll
                    for (int n = 0; n < 2; ++n) acc[a][b][m][n] = (f32x4){0.f, 0.f, 0.f, 0.f};
        cur = nxt; cA = nA; cB = nB; ++ui;
        if constexpr (ALIGN_EPI) { if (wr == 1) PG8_BAR; }
    }
    PG8_WAIT_V(0);
    if constexpr (!ALIGN_EPI) { if (wr == 0) PG8_BAR; }
    PG8_BAR;
    if constexpr (Epi::AFTER_DRAIN) { E.fused(acc, cur, wr, wc, fr, fq, lds, wid, lane); S.done(cur); }
#undef PG8_SA
#undef PG8_SB
#undef PG8_STAGE
#undef PG8_LDA
#undef PG8_LDB
#undef PG8_MMA
#undef PG8_WAIT_V
#undef PG8_WAIT_L
#undef PG8_BAR
#undef PG8_SCHED
}
}
using pg8::bf16_t; using pg8::bf16x8; using pg8::f32x4; using pg8::Unit; using pg8::cvt_pk_bf16;
typedef short bf16x4 __attribute__((ext_vector_type(4)));
typedef unsigned u32x2 __attribute__((ext_vector_type(2)));
typedef unsigned u32x4v __attribute__((ext_vector_type(4)));

constexpr int D_MODEL = 1024, BATCH = 32, SEQ = 2048, DEPTH = 4, DEC_BATCH = 16, DEC_SEQ = 16, PAST = 2048;
constexpr int N_HEADS = 8, Q_LORA = 384, KV_LORA = 256, ROPE_D = 32, CONF_CH = 256, SC_CH = 256, D_FF = 4096, N_IN = 5024;
constexpr int MP = BATCH * SEQ;
constexpr int MS = DEC_BATCH * DEC_SEQ;
constexpr int M = MP + MS;
constexpr int SROW = 2112;
constexpr int MA = MP + DEC_BATCH * SROW;
constexpr int NPOS = PAST + DEC_SEQ;
constexpr int PW = 2048;
constexpr float DN_ALPHA = 1.681792830507429f;
constexpr float LN_EPS = 1e-5f, RMS_EPS = 1e-6f;
constexpr float QSCALE = 0.10206207261596577f * 1.4426950408889634f;
constexpr int PC_Q = 0, PC_KV = 384, PC_KR = 640, PC_CA = 672, PC_CG = 928, PC_GB = 1184, PC_GC = 1440, PC_H = 1696;

constexpr size_t WO_A = 0, WO_G = 2097152, WO_UQ = 5242880, WO_UK = 5537792, WO_UV = 5668864, WO_MLA = 5799936, WO_CONF = 6324224, WO_SC = 6586368,
                 WO_MIX = 6848512, WO_FF1 = 7897088, WO_FF2 = 12091392, W_LAYER = 16285696;
constexpr size_t OFF_W = 0, OFF_ROPE = W_LAYER * 2 * DEPTH, OFF_XB = OFF_ROPE + (size_t)NPOS * 32 * 4, OFF_BIG = OFF_XB + (size_t)M * 1024 * 2,
                 G3SZ = (size_t)M * 3072 * 2;
constexpr size_t B_G3 = 0, B_QN = G3SZ, B_CKV = B_QN + (size_t)M * 384 * 2, B_KR = B_CKV + (size_t)MA * 256 * 2, B_CVN = B_KR + (size_t)MA * 32 * 2,
                 B_SCZ = B_CVN + (size_t)M * 256 * 2, B_O = B_SCZ + (size_t)M * 256 * 2, B_END = B_O + (size_t)M * 512 * 2;
constexpr size_t BIGSZ = B_END > (size_t)M * 4096 * 2 ? B_END : (size_t)M * 4096 * 2;
constexpr size_t OFF_VT = OFF_BIG + BIGSZ, WS_END = OFF_VT + (size_t)512 * MA * 2;
constexpr size_t D_P = 0, D_Q = 0, D_KN = (size_t)M * 768 * 2, D_MG = 0;
static_assert(D_KN + (size_t)MA * 512 * 2 <= (size_t)M * 1024 * 4, "d_out scratch overflow");
static_assert((size_t)M * PW * 2 <= (size_t)M * 1024 * 4, "P overflow");
constexpr size_t OO_Y = 0, OO_CKVP = (size_t)M * 1024, OO_KRP = OO_CKVP + (size_t)DEPTH * MP * 256, OO_CONFP = OO_KRP + (size_t)DEPTH * MP * 32,
                 OO_SCP = OO_CONFP + (size_t)DEPTH * BATCH * 30 * 256, OO_CKVS = OO_SCP + (size_t)DEPTH * BATCH * 2 * 256, OO_KRS = OO_CKVS + (size_t)DEPTH * MS * 256,
                 OO_CONFS = OO_KRS + (size_t)DEPTH * MS * 32, OO_SCS = OO_CONFS + (size_t)DEPTH * DEC_BATCH * 30 * 256, OO_END = OO_SCS + (size_t)DEPTH * DEC_BATCH * 2 * 256;

struct Params {
    const float* in[30];
    float* out; unsigned char* ws;
    float inv[16];
};
typedef const Params __attribute__((address_space(4)))* KP;
enum { I_XP = 0, I_XS, I_CCKV, I_CKR, I_SCONF, I_SSC, I_WIN, I_BGATE, I_QNG, I_WUQ, I_KVNG, I_WUK, I_WUV, I_WMLA, I_CDW, I_CDB, I_CLG, I_CLB, I_WCONF, I_SDW, I_WSC, I_WMIX,
       I_LN1G, I_LN1B, I_WFF1, I_BFF1, I_WFF2, I_BFF2, I_LN2G, I_LN2B };

__device__ __forceinline__ float bf2f(bf16_t b) { return __uint_as_float(((unsigned)b) << 16); }
__device__ __forceinline__ float bflo(unsigned u) { return __uint_as_float(u << 16); }
__device__ __forceinline__ float bfhi(unsigned u) { return __uint_as_float(u & 0xffff0000u); }
__device__ __forceinline__ bf16_t f2bf(float f) { return (bf16_t)(cvt_pk_bf16(f, 0.f) & 0xffffu); }
__device__ __forceinline__ float sigmoidf_(float x) { return __builtin_amdgcn_rcpf(1.f + __builtin_amdgcn_exp2f(-1.4426950408889634f * x)); }
__device__ __forceinline__ float shx(float v, int o, int lane) { return __int_as_float(__builtin_amdgcn_ds_bpermute((lane ^ o) << 2, __float_as_int(v))); }
__device__ __forceinline__ float wave_sum(float v, int lane) {
#pragma unroll
    for (int o = 32; o > 0; o >>= 1) v += shx(v, o, lane);
    return v;
}

__device__ __forceinline__ int lane_id_v() { int l; asm volatile("v_mbcnt_lo_u32_b32 %0, -1, 0\n\tv_mbcnt_hi_u32_b32 %0, -1, %0" : "=v"(l)); return l; }
template <int MODE> struct EpiB {
    static constexpr bool PERM = true, AFTER_DRAIN = false;
    bf16_t* O; int ldc; const float* bias; const bf16_t* G; int ldg;
    __device__ __forceinline__ void operator()(const f32x4 (&acc)[2][2][4][2], const Unit& u, int wr, int wc, int fr_, int fq_) const {
        const int lane_ = lane_id_v(), fr = lane_ & 15, fq = lane_ >> 4;
        const int row0 = u.pm * 256 + wr * 64 + fr, col0 = u.pn * 256 + wc * 32 + 8 * fq;
        f32x4 bv[2][2];
#pragma unroll
        for (int bj = 0; bj < 2; ++bj)
#pragma unroll
            for (int n = 0; n < 2; ++n) bv[bj][n] = (MODE == 1 || MODE == 2 || (MODE == 5 && bias != nullptr)) ? *(const f32x4*)(bias + col0 + bj * 128 + 4 * n) : (f32x4){0.f, 0.f, 0.f, 0.f};
        u32x4v gq[2][4][2], pq[2][4][2];
        if (MODE == 3 || MODE == 5) {
#pragma unroll
            for (int ai = 0; ai < 2; ++ai)
#pragma unroll
                for (int m = 0; m < 4; ++m)
#pragma unroll
                    for (int bj = 0; bj < 2; ++bj) {
                        const size_t rowi = (size_t)(row0 + ai * 128 + m * 16);
                        if (MODE == 3) gq[ai][m][bj] = *(const u32x4v*)(G + rowi * ldg + col0 + bj * 128);
                        if (MODE == 5) pq[ai][m][bj] = *(const u32x4v*)(O + rowi * ldc + col0 + bj * 128);
                    }
        }
#pragma unroll
        for (int ai = 0; ai < 2; ++ai) {
            if (MODE == 4) {
#pragma unroll
                for (int m = 0; m < 4; ++m)
#pragma unroll
                    for (int bj = 0; bj < 2; ++bj) {
                        const size_t rowi = (size_t)(row0 + ai * 128 + m * 16);
                        gq[ai][m][bj] = *(const u32x4v*)(G + rowi * ldg + col0 + bj * 128);
                        pq[ai][m][bj] = *(const u32x4v*)(O + rowi * ldc + col0 + bj * 128);
                    }
            }
#pragma unroll
            for (int m = 0; m < 4; ++m) {
                const size_t ro = (size_t)(row0 + ai * 128 + m * 16) * ldc + col0;
#pragma unroll
                for (int bj = 0; bj < 2; ++bj) {
                    f32x4 v0 = acc[ai][bj][m][0] + bv[bj][0], v1 = acc[ai][bj][m][1] + bv[bj][1];
                    if (MODE == 1) {
#pragma unroll
                        for (int j = 0; j < 4; ++j) { float a = fmaxf(v0[j], 0.f), b = fmaxf(v1[j], 0.f); v0[j] = a * a; v1[j] = b * b; }
                    } else if (MODE == 2) {
#pragma unroll
                        for (int j = 0; j < 4; ++j) { v0[j] = sigmoidf_(v0[j]); v1[j] = sigmoidf_(v1[j]); }
                    } else if (MODE == 5) {
                        const u32x4v pp = pq[ai][m][bj];
                        v0[0] += DN_ALPHA * bflo(pp[0]); v0[1] += DN_ALPHA * bfhi(pp[0]); v0[2] += DN_ALPHA * bflo(pp[1]); v0[3] += DN_ALPHA * bfhi(pp[1]);
                        v1[0] += DN_ALPHA * bflo(pp[2]); v1[1] += DN_ALPHA * bfhi(pp[2]); v1[2] += DN_ALPHA * bflo(pp[3]); v1[3] += DN_ALPHA * bfhi(pp[3]);
                    } else if (MODE == 3 || MODE == 4) {
                        const u32x4v gg = gq[ai][m][bj];
                        v0[0] *= bflo(gg[0]); v0[1] *= bfhi(gg[0]); v0[2] *= bflo(gg[1]); v0[3] *= bfhi(gg[1]);
                        v1[0] *= bflo(gg[2]); v1[1] *= bfhi(gg[2]); v1[2] *= bflo(gg[3]); v1[3] *= bfhi(gg[3]);
                        if (MODE == 4) {
                            const u32x4v pp = pq[ai][m][bj];
                            v0[0] += bflo(pp[0]); v0[1] += bfhi(pp[0]); v0[2] += bflo(pp[1]); v0[3] += bfhi(pp[1]);
                            v1[0] += bflo(pp[2]); v1[1] += bfhi(pp[2]); v1[2] += bflo(pp[3]); v1[3] += bfhi(pp[3]);
                        }
                    }
                    u32x4v o; o[0] = cvt_pk_bf16(v0[0], v0[1]); o[1] = cvt_pk_bf16(v0[2], v0[3]); o[2] = cvt_pk_bf16(v1[0], v1[1]); o[3] = cvt_pk_bf16(v1[2], v1[3]);
                    *(u32x4v*)(O + ro + bj * 128) = o;
                }
            }
        }
    }
};
struct EpiPG {
    static constexpr bool PERM = true, AFTER_DRAIN = false;
    bf16_t* P; bf16_t* G3; const float* bias;
    __device__ __forceinline__ void operator()(const f32x4 (&acc)[2][2][4][2], const Unit& u, int wr, int wc, int fr, int fq) const {
        if (u.pn < 8) { EpiB<0> e; e.O = P; e.ldc = PW; e.bias = nullptr; e.G = nullptr; e.ldg = 0; e(acc, u, wr, wc, fr, fq); }
        else { EpiB<2> e; e.O = G3; e.ldc = 3072; e.bias = bias; e.G = nullptr; e.ldg = 0; Unit u2; u2.pm = u.pm; u2.pn = u.pn - 8; e(acc, u2, wr, wc, fr, fq); }
    }
};
__device__ __forceinline__ int row_pos(int row) { return row < MP ? (row & (SEQ - 1)) : PAST + ((row - MP) & (DEC_SEQ - 1)); }
struct EpiQ {
    static constexpr bool PERM = false, AFTER_DRAIN = false;
    bf16_t* O; const float* rope;
    __device__ __forceinline__ void operator()(const f32x4 (&acc)[2][2][4][2], const Unit& u, int wr, int wc, int fr_, int fq_) const {
        const int lane_ = lane_id_v(), fr = lane_ & 15, fq = lane_ >> 4;
        const int row0 = u.pm * 256 + wr * 64 + fr, col0 = u.pn * 256 + wc * 32 + 4 * fq;
#pragma unroll
        for (int ai = 0; ai < 2; ++ai) {
            f32x4 csv[4], snv[4];
#pragma unroll
            for (int m = 0; m < 4; ++m) { const float* rp = rope + (size_t)row_pos(row0 + ai * 128 + m * 16) * 32 + 4 * fq; csv[m] = *(const f32x4*)rp; snv[m] = *(const f32x4*)(rp + 16); }
#pragma unroll
            for (int m = 0; m < 4; ++m) {
                const int row = row0 + ai * 128 + m * 16;
                const f32x4 cs = csv[m], sn = snv[m];
#pragma unroll
                for (int bj = 0; bj < 2; ++bj) {
                    const int grp = u.pn * 8 + bj * 4 + wc;
                    f32x4 v0 = acc[ai][bj][m][0], v1 = acc[ai][bj][m][1];
                    if (grp % 3 == 2) { const f32x4 a = v0 * cs - v1 * sn, b = v0 * sn + v1 * cs; v0 = a; v1 = b; }
                    v0 *= QSCALE; v1 *= QSCALE;
                    bf16_t* p = O + (size_t)row * 768 + col0 + bj * 128;
                    u32x2 o0, o1; o0[0] = cvt_pk_bf16(v0[0], v0[1]); o0[1] = cvt_pk_bf16(v0[2], v0[3]); o1[0] = cvt_pk_bf16(v1[0], v1[1]); o1[1] = cvt_pk_bf16(v1[2], v1[3]);
                    *(u32x2*)p = o0; *(u32x2*)(p + 16) = o1;
                }
            }
        }
    }
};
template <bool BIAS> struct EpiRes {
    static constexpr bool PERM = false, AFTER_DRAIN = false;
    float* X; const float* bias;
    __device__ __forceinline__ void operator()(const f32x4 (&acc)[2][2][4][2], const Unit& u, int wr, int wc, int fr_, int fq_) const {
        const int lane_ = lane_id_v(), fr = lane_ & 15, fq = lane_ >> 4;
        const int row0 = u.pm * 256 + wr * 64 + fr, col0 = u.pn * 256 + wc * 32 + 4 * fq;
        f32x4 bv[2][2];
#pragma unroll
        for (int bj = 0; bj < 2; ++bj)
#pragma unroll
            for (int n = 0; n < 2; ++n) bv[bj][n] = BIAS ? *(const f32x4*)(bias + col0 + bj * 128 + n * 16) : (f32x4){0.f, 0.f, 0.f, 0.f};
#pragma unroll
        for (int ai = 0; ai < 2; ++ai)
#pragma unroll
            for (int m = 0; m < 4; ++m) {
                float* rowp = X + (size_t)(row0 + ai * 128 + m * 16) * 1024 + col0;
#pragma unroll
                for (int bj = 0; bj < 2; ++bj)
#pragma unroll
                    for (int n = 0; n < 2; ++n) { f32x4* p = (f32x4*)(rowp + bj * 128 + n * 16); *p = *p * DN_ALPHA + acc[ai][bj][m][n] + bv[bj][n]; }
            }
    }
};

#ifndef USE_SIMPLE
#define USE_SIMPLE 1
#endif
template <class Epi>
__device__ __forceinline__ void gemm_simple(PG8_LAS unsigned char* lds, int tid_in, const bf16_t* __restrict__ A, const bf16_t* __restrict__ Bt, int Mr, int N, int K, const Epi& E) {
    using namespace pg8;
    int tid_ = tid_in; asm volatile("" : "+v"(tid_));
    const int tid = tid_, wid = tid >> 6, lane = tid & 63, wr = wid >> 2, wc = wid & 3, fr = lane & 15, fq = lane >> 4;
    const int nt = K / 64;
    const int aoff = lds_byte(wr * 64 + fr, fq * 8), boff = lds_byte(wc * 32 + fr, fq * 8);
    int sl[2]; size_t ga[2], gb[2];
#pragma unroll
    for (int i = 0; i < 2; ++i) { const int q = tid + i * 512, r = q >> 3, c8 = (q & 7) * 8, rb = Epi::PERM ? ((r & ~31) + perm32(r & 31)) : r;
        sl[i] = lds_byte(r, c8); ga[i] = (size_t)r * K + c8; gb[i] = (size_t)rb * K + c8; }
    StaticOrder S; S.init(Mr, N, (int)gridDim.x, (int)blockIdx.x);
    Unit un;
    for (int ui = 0; S.next(ui, un); ++ui) {
        f32x4 acc[2][2][4][2];
#pragma unroll
        for (int a = 0; a < 2; ++a)
#pragma unroll
            for (int b = 0; b < 2; ++b)
#pragma unroll
                for (int m = 0; m < 4; ++m)
#pragma unroll
                    for (int n = 0; n < 2; ++n) acc[a][b][m][n] = (f32x4){0.f, 0.f, 0.f, 0.f};
        const bf16_t* Ab = A + (size_t)un.pm * 256 * K; const bf16_t* Bb = Bt + (size_t)un.pn * 256 * K;
        u32x4v ra[2][2], rb[2][2];
#define SG_GLOAD(kt) do { _Pragma("unroll") for (int h = 0; h < 2; ++h) _Pragma("unroll") for (int i = 0; i < 2; ++i) { \
            ra[h][i] = *(const u32x4v*)(Ab + (size_t)h * 128 * K + ga[i] + (kt) * 64); rb[h][i] = *(const u32x4v*)(Bb + (size_t)h * 128 * K + gb[i] + (kt) * 64); } } while (0)
#define SG_LSTORE(b) do { _Pragma("unroll") for (int h = 0; h < 2; ++h) _Pragma("unroll") for (int i = 0; i < 2; ++i) { \
            *(PG8_LAS u32x4v*)(lds + ((b) * 4 + h) * HTB + sl[i]) = ra[h][i]; *(PG8_LAS u32x4v*)(lds + ((b) * 4 + 2 + h) * HTB + sl[i]) = rb[h][i]; } } while (0)
        SG_GLOAD(0); SG_LSTORE(0); __syncthreads();
        for (int kt = 0; kt < nt; ++kt) {
            const int b = kt & 1;
            if (kt + 1 < nt) SG_GLOAD(kt + 1);
#pragma unroll
            for (int ai = 0; ai < 2; ++ai) {
                bf16x8 At[4][2];
#pragma unroll
                for (int m = 0; m < 4; ++m)
#pragma unroll
                    for (int k = 0; k < 2; ++k) At[m][k] = *(const PG8_LAS bf16x8*)(lds + (b * 4 + ai) * HTB + aoff + m * 2048 + k * 1024);
#pragma unroll
                for (int bj = 0; bj < 2; ++bj) {
                    bf16x8 Bf[2][2];
#pragma unroll
                    for (int n = 0; n < 2; ++n)
#pragma unroll
                        for (int k = 0; k < 2; ++k) Bf[n][k] = *(const PG8_LAS bf16x8*)(lds + (b * 4 + 2 + bj) * HTB + boff + n * 2048 + k * 1024);
#pragma unroll
                    for (int m = 0; m < 4; ++m)
#pragma unroll
                        for (int n = 0; n < 2; ++n)
#pragma unroll
                            for (int k = 0; k < 2; ++k) acc[ai][bj][m][n] = __builtin_amdgcn_mfma_f32_16x16x32_bf16(Bf[n][k], At[m][k], acc[ai][bj][m][n], 0, 0, 0);
                }
            }
            if (kt + 1 < nt) SG_LSTORE(b ^ 1);
            __syncthreads();
        }
#undef SG_GLOAD
#undef SG_LSTORE
        E(acc, un, wr, wc, fr, fq);
    }
}

template <class Epi> __device__ __forceinline__ void run_gemm(PG8_LAS unsigned char* lds, int tid, const bf16_t* A, const bf16_t* Bt, int Mr, int N, int K, const Epi& E, int xr = 0) {
#if USE_SIMPLE
    gemm_simple<Epi>(lds, tid, A, Bt, Mr, N, K, E);
#else
    pg8::Gemm g; g.A = A; g.Bt = Bt; g.M = Mr; g.N = N; g.K = K;
    pg8::StaticOrder S; S.init(Mr, N, (int)gridDim.x, (int)blockIdx.x ^ xr);
    pg8::gemm_phase<Epi, pg8::StaticOrder, GEMM_ALIGN, GEMM_SP2>(lds, tid, g, S, E);
#endif
}
struct TJob { int in_idx, K, Nd, Nvalid, ld, coloff; size_t dst; int tiles; };
__device__ __forceinline__ TJob tjob(int j) {
    switch (j) {
        case 0: return {I_WIN, 1024, 2048, 1952, N_IN, 0, WO_A, 512};
        case 1: return {I_WIN, 1024, 3072, 3072, N_IN, 1952, WO_G, 768};
        case 2: return {I_WUQ, 384, 768, 768, 768, 0, WO_UQ, 72};
        case 3: return {I_WUK, 256, 512, 512, 512, 0, WO_UK, 32};
        case 4: return {I_WUV, 256, 512, 512, 512, 0, WO_UV, 32};
        case 5: return {I_WMLA, 512, 1024, 1024, 1024, 0, WO_MLA, 128};
        case 6: return {I_WCONF, 256, 1024, 1024, 1024, 0, WO_CONF, 64};
        case 7: return {I_WSC, 256, 1024, 1024, 1024, 0, WO_SC, 64};
        case 8: return {I_WMIX, 1024, 1024, 1024, 1024, 0, WO_MIX, 256};
        case 9: return {I_WFF1, 1024, 4096, 4096, 4096, 0, WO_FF1, 1024};
        default: return {I_WFF2, 4096, 1024, 1024, 1024, 0, WO_FF2, 1024};
    }
}
constexpr int TILES_PER_LAYER = 512 + 768 + 72 + 32 + 32 + 128 + 64 + 64 + 256 + 1024 + 1024;

__device__ __forceinline__ void convert_weights(KP p, float* lds, int tid_in, int l, int b0) {
    if ((int)blockIdx.x < b0) return;
    int tid = tid_in; asm volatile("" : "+v"(tid));
    bf16_t* W = (bf16_t*)(p->ws + OFF_W);
    for (int t = (int)blockIdx.x - b0; t < TILES_PER_LAYER; t += (int)gridDim.x - b0) {
        int r = t; int j = 0; TJob jb = tjob(0);
        while (r >= jb.tiles) { r -= jb.tiles; ++j; jb = tjob(j); }
        const int nk = jb.K / 64, kt = r % nk, ntile = r / nk, k0 = kt * 64, n0 = ntile * 64;
        const float* src = p->in[jb.in_idx] + (size_t)l * jb.K * jb.ld + jb.coloff;
        __syncthreads();
#pragma unroll
        for (int i = 0; i < 8; ++i) {
            const int e = tid + i * 512, kk = e >> 6, nn = e & 63;
            lds[kk * 65 + nn] = (n0 + nn < jb.Nvalid) ? src[(size_t)(k0 + kk) * jb.ld + n0 + nn] : 0.f;
        }
        __syncthreads();
        const int nn = tid >> 3, kk0 = (tid & 7) * 8;
        u32x4v o;
#pragma unroll
        for (int q = 0; q < 4; ++q) o[q] = cvt_pk_bf16(lds[(kk0 + 2 * q) * 65 + nn], lds[(kk0 + 2 * q + 1) * 65 + nn]);
        *(u32x4v*)(W + (size_t)l * W_LAYER + jb.dst + (size_t)(n0 + nn) * jb.K + k0 + kk0) = o;
    }
}
__device__ void phase_prologue(KP p, float* lds, int tid_in) {
    int tid = tid_in; asm volatile("" : "+v"(tid));
    convert_weights(p, lds, tid, 0, 0);
    {
        bf16_t* Xb = (bf16_t*)(p->ws + OFF_XB);
        const size_t n4 = (size_t)M * 1024 / 4, np4 = (size_t)MP * 1024 / 4;
        for (size_t i = (size_t)blockIdx.x * 512 + tid; i < n4; i += (size_t)gridDim.x * 512) {
            const f32x4 v = i < np4 ? ((const f32x4*)p->in[I_XP])[i] : ((const f32x4*)p->in[I_XS])[i - np4];
            u32x2 o; o[0] = cvt_pk_bf16(v[0], v[1]); o[1] = cvt_pk_bf16(v[2], v[3]);
            ((u32x2*)Xb)[i] = o;
        }
    }
    {
        float* rope = (float*)(p->ws + OFF_ROPE);
        for (int i = blockIdx.x * 512 + tid; i < NPOS * 16; i += gridDim.x * 512) {
            const int pos = i >> 4, k = i & 15;
            const float ang = (float)pos * p->inv[k];
            double fr = (double)ang * 0.15915494309189535; fr -= floor(fr);
            rope[pos * 32 + k] = __builtin_amdgcn_cosf((float)fr);
            rope[pos * 32 + 16 + k] = __builtin_amdgcn_sinf((float)fr);
        }
    }
}

__device__ __forceinline__ f32x4 bf4lo(const u32x4v& u) { return (f32x4){bflo(u[0]), bfhi(u[0]), bflo(u[1]), bfhi(u[1])}; }
__device__ __forceinline__ f32x4 bf4hi(const u32x4v& u) { return (f32x4){bflo(u[2]), bfhi(u[2]), bflo(u[3]), bfhi(u[3])}; }
__device__ __forceinline__ f32x4 sig4(const f32x4& v) { return (f32x4){sigmoidf_(v[0]), sigmoidf_(v[1]), sigmoidf_(v[2]), sigmoidf_(v[3])}; }
template <int NTOK, bool SMP>
__device__ __forceinline__ void mix_tile(KP p, int l, float* lds, int tid, int s, int t0) {
    const int wid = tid >> 6, lane = tid & 63;
    unsigned char* big = p->ws + OFF_BIG;
    const bf16_t* P = (const bf16_t*)((const unsigned char*)p->out + D_P);
    bf16_t* QN = (bf16_t*)(big + B_QN); bf16_t* CKV = (bf16_t*)(big + B_CKV); bf16_t* KR = (bf16_t*)(big + B_KR);
    bf16_t* CVN = (bf16_t*)(big + B_CVN); bf16_t* SCZ = (bf16_t*)(big + B_SCZ);
    const float* rope = (const float*)(p->ws + OFF_ROPE);
    float* us = lds;
    float* cvs = lds + 62 * 256;
    constexpr int T = SMP ? DEC_SEQ : SEQ, NR = NTOK + 30, TPW = NTOK / 8, NH = NTOK / 2;
    const int mrow0 = SMP ? MP + s * DEC_SEQ : s * SEQ + t0;
    const int arow0 = SMP ? MP + s * SROW + PAST : s * SEQ + t0;
    const int pos0 = SMP ? PAST : t0;
    float* ckv_out = p->out + (SMP ? OO_CKVS + ((size_t)(l * DEC_BATCH + s) * DEC_SEQ) * 256 : OO_CKVP + ((size_t)(l * BATCH + s) * SEQ + t0) * 256);
    float* kr_out = p->out + (SMP ? OO_KRS + ((size_t)(l * DEC_BATCH + s) * DEC_SEQ) * 32 : OO_KRP + ((size_t)(l * BATCH + s) * SEQ + t0) * 32);
    __syncthreads();
    {
        unsigned xq[TPW][3]; u32x2 xkv[TPW]; float k1[TPW], k2[TPW];
#pragma unroll
        for (int k = 0; k < TPW; ++k) {
            const bf16_t* pr = P + (size_t)(mrow0 + wid + 8 * k) * PW;
#pragma unroll
            for (int j = 0; j < 3; ++j) xq[k][j] = *(const unsigned*)(pr + PC_Q + 2 * lane + 128 * j);
            xkv[k] = *(const u32x2*)(pr + PC_KV + 4 * lane);
            k1[k] = bf2f(pr[PC_KR + (lane & 15)]); k2[k] = bf2f(pr[PC_KR + 16 + (lane & 15)]);
        }
        const float* gq = p->in[I_QNG] + l * Q_LORA;
        float gqv[6];
#pragma unroll
        for (int j = 0; j < 3; ++j) { gqv[2 * j] = gq[2 * lane + 128 * j]; gqv[2 * j + 1] = gq[2 * lane + 128 * j + 1]; }
        const f32x4 gkv = *(const f32x4*)(p->in[I_KVNG] + l * KV_LORA + 4 * lane);
#pragma unroll
        for (int k = 0; k < TPW; ++k) {
            const int i = wid + 8 * k;
            {
                float x[6]; float ss = 0.f;
#pragma unroll
                for (int j = 0; j < 3; ++j) { x[2 * j] = bflo(xq[k][j]); x[2 * j + 1] = bfhi(xq[k][j]); ss += x[2 * j] * x[2 * j] + x[2 * j + 1] * x[2 * j + 1]; }
                ss = wave_sum(ss, lane); const float r = rsqrtf(ss * (1.f / 384.f) + RMS_EPS);
#pragma unroll
                for (int j = 0; j < 3; ++j) *(unsigned*)(QN + (size_t)(mrow0 + i) * 384 + 2 * lane + 128 * j) = cvt_pk_bf16(x[2 * j] * r * gqv[2 * j], x[2 * j + 1] * r * gqv[2 * j + 1]);
            }
            {
                f32x4 x = {bflo(xkv[k][0]), bfhi(xkv[k][0]), bflo(xkv[k][1]), bfhi(xkv[k][1])};
                float ss = x[0] * x[0] + x[1] * x[1] + x[2] * x[2] + x[3] * x[3];
                ss = wave_sum(ss, lane); const float r = rsqrtf(ss * (1.f / 256.f) + RMS_EPS);
                x = x * r * gkv;
                *(f32x4*)(ckv_out + (size_t)i * 256 + 4 * lane) = x;
                u32x2 o; o[0] = cvt_pk_bf16(x[0], x[1]); o[1] = cvt_pk_bf16(x[2], x[3]);
                *(u32x2*)(CKV + (size_t)(arow0 + i) * 256 + 4 * lane) = o;
            }
            if (lane < 16) {
                const float cs = rope[(pos0 + i) * 32 + lane], sn = rope[(pos0 + i) * 32 + 16 + lane];
                const float o1 = k1[k] * cs - k2[k] * sn, o2 = k1[k] * sn + k2[k] * cs;
                kr_out[(size_t)i * 32 + lane] = o1; kr_out[(size_t)i * 32 + 16 + lane] = o2;
                KR[(size_t)(arow0 + i) * 32 + lane] = f2bf(o1); KR[(size_t)(arow0 + i) * 32 + 16 + lane] = f2bf(o2);
            }
        }
    }
    const int cg8 = (tid & 31) * 8, rsub = tid >> 5;
    {
        constexpr int NP = (NR + 15) / 16;
#pragma unroll
        for (int ps = 0; ps < NP; ++ps) {
            const int j = rsub + 16 * ps;
            if (j < NR) {
                const int t = t0 - 30 + j;
                f32x4 u0 = {0.f, 0.f, 0.f, 0.f}, u1 = {0.f, 0.f, 0.f, 0.f};
                if (t >= 0) {
                    const bf16_t* pr = P + (size_t)(mrow0 - t0 + t) * PW;
                    const u32x4v a = *(const u32x4v*)(pr + PC_CA + cg8), g = *(const u32x4v*)(pr + PC_CG + cg8);
                    u0 = bf4lo(a) * sig4(bf4lo(g)); u1 = bf4hi(a) * sig4(bf4hi(g));
                } else if (SMP) {
                    const float* h = p->in[I_SCONF] + ((size_t)(l * DEC_BATCH + s) * 30 + (30 + t)) * 256 + cg8;
                    u0 = *(const f32x4*)h; u1 = *(const f32x4*)(h + 4);
                }
                *(f32x4*)(us + j * 256 + cg8) = u0; *(f32x4*)(us + j * 256 + cg8 + 4) = u1;
            }
        }
    }
    {
        const float* sw = p->in[I_SDW] + (size_t)l * 3 * 256 + cg8;
        const f32x4 w0a = *(const f32x4*)sw, w0b = *(const f32x4*)(sw + 4), w1a = *(const f32x4*)(sw + 256), w1b = *(const f32x4*)(sw + 260), w2a = *(const f32x4*)(sw + 512), w2b = *(const f32x4*)(sw + 516);
        float* so = p->out + (SMP ? OO_SCS + (size_t)(l * DEC_BATCH + s) * 2 * 256 : OO_SCP + (size_t)(l * BATCH + s) * 2 * 256);
#pragma unroll
        for (int ps = 0; ps < NTOK / 16; ++ps) {
            const int i = rsub + 16 * ps, t = t0 + i;
            f32x4 z[3][2];
#pragma unroll
            for (int d = 0; d < 3; ++d) {
                const int tt = t - 2 + d;
                z[d][0] = (f32x4){0.f, 0.f, 0.f, 0.f}; z[d][1] = (f32x4){0.f, 0.f, 0.f, 0.f};
                if (tt >= 0) {
                    const bf16_t* pr = P + (size_t)(mrow0 - t0 + tt) * PW;
                    const u32x4v gc = *(const u32x4v*)(pr + PC_GC + cg8), hh = *(const u32x4v*)(pr + PC_H + cg8);
                    z[d][0] = bf4lo(gc) * bf4lo(hh); z[d][1] = bf4hi(gc) * bf4hi(hh);
                } else if (SMP) {
                    const float* hs = p->in[I_SSC] + ((size_t)(l * DEC_BATCH + s) * 2 + (2 + tt)) * 256 + cg8;
                    z[d][0] = *(const f32x4*)hs; z[d][1] = *(const f32x4*)(hs + 4);
                }
            }
            const u32x4v gb = *(const u32x4v*)(P + (size_t)(mrow0 + i) * PW + PC_GB + cg8);
            const f32x4 c0 = (w0a * z[0][0] + w1a * z[1][0] + w2a * z[2][0]) * bf4lo(gb), c1 = (w0b * z[0][1] + w1b * z[1][1] + w2b * z[2][1]) * bf4hi(gb);
            u32x4v o; o[0] = cvt_pk_bf16(c0[0], c0[1]); o[1] = cvt_pk_bf16(c0[2], c0[3]); o[2] = cvt_pk_bf16(c1[0], c1[1]); o[3] = cvt_pk_bf16(c1[2], c1[3]);
            *(u32x4v*)(SCZ + (size_t)(mrow0 + i) * 256 + cg8) = o;
            if (t >= T - 2) { float* sp = so + (t - (T - 2)) * 256 + cg8; *(f32x4*)sp = z[2][0]; *(f32x4*)(sp + 4) = z[2][1]; }
        }
    }
    __syncthreads();
    {
        const int c = tid & 255, half = tid >> 8, i0 = half * NH;
        float w[31];
#pragma unroll
        for (int k = 0; k < 31; ++k) w[k] = p->in[I_CDW][((size_t)l * 31 + k) * 256 + c];
        const float b = p->in[I_CDB][l * 256 + c];
        float ur[NH + 30];
#pragma unroll
        for (int k = 0; k < NH + 30; ++k) ur[k] = us[(i0 + k) * 256 + c];
#pragma unroll
        for (int i = 0; i < NH; ++i) {
            float a = b;
#pragma unroll
            for (int k = 0; k < 31; ++k) a += w[k] * ur[i + k];
            cvs[(i0 + i) * 256 + c] = a;
        }
        if (t0 + NTOK == T) {
            float* co = p->out + (SMP ? OO_CONFS + (size_t)(l * DEC_BATCH + s) * 30 * 256 : OO_CONFP + (size_t)(l * BATCH + s) * 30 * 256);
            for (int j = half; j < 30; j += 2) co[j * 256 + c] = us[(NTOK + j) * 256 + c];
        }
    }
    __syncthreads();
    {
        const f32x4 g = *(const f32x4*)(p->in[I_CLG] + l * 256 + 4 * lane), bb = *(const f32x4*)(p->in[I_CLB] + l * 256 + 4 * lane);
#pragma unroll
        for (int k = 0; k < TPW; ++k) {
            const int i = wid + 8 * k;
            const f32x4 x = *(const f32x4*)(cvs + i * 256 + 4 * lane);
            const float mu = wave_sum(x[0] + x[1] + x[2] + x[3], lane) * (1.f / 256.f);
            const f32x4 d = x - mu;
            const float var = wave_sum(d[0] * d[0] + d[1] * d[1] + d[2] * d[2] + d[3] * d[3], lane) * (1.f / 256.f);
            const float r = rsqrtf(var + LN_EPS);
            f32x4 y = d * r * g + bb;
#pragma unroll
            for (int j = 0; j < 4; ++j) y[j] = y[j] * sigmoidf_(y[j]);
            u32x2 o; o[0] = cvt_pk_bf16(y[0], y[1]); o[1] = cvt_pk_bf16(y[2], y[3]);
            *(u32x2*)(CVN + (size_t)(mrow0 + i) * 256 + 4 * lane) = o;
        }
    }
}

__device__ void phase_mixprep(KP p, int l, float* lds, int tid_in) {
    int tid_ = tid_in; asm volatile("" : "+v"(tid_));
    const int tid = tid_;
    unsigned char* big = p->ws + OFF_BIG;
    bf16_t* CKV = (bf16_t*)(big + B_CKV); bf16_t* KR = (bf16_t*)(big + B_KR);
    for (int it = blockIdx.x; it < 2576; it += gridDim.x) {
        if (it >= 2064) {
            const int c = it - 2064, s = c >> 5, r0 = (c & 31) * 64;
            const float* src = p->in[I_CCKV] + ((size_t)(l * DEC_BATCH + s) * PAST + r0) * 256;
            bf16_t* dst = CKV + (size_t)(MP + s * SROW + r0) * 256;
#pragma unroll
            for (int i = 0; i < 8; ++i) { const int e = tid + i * 512; const f32x4 v = ((const f32x4*)src)[e]; u32x2 o; o[0] = cvt_pk_bf16(v[0], v[1]); o[1] = cvt_pk_bf16(v[2], v[3]); ((u32x2*)dst)[e] = o; }
            const float* src2 = p->in[I_CKR] + ((size_t)(l * DEC_BATCH + s) * PAST + r0) * 32;
            bf16_t* dst2 = KR + (size_t)(MP + s * SROW + r0) * 32;
            { const f32x4 v = ((const f32x4*)src2)[tid]; u32x2 o; o[0] = cvt_pk_bf16(v[0], v[1]); o[1] = cvt_pk_bf16(v[2], v[3]); ((u32x2*)dst2)[tid] = o; }
            if ((c & 31) == 0) {
                bf16_t* z = CKV + (size_t)(MP + s * SROW + PAST + DEC_SEQ) * 256;
                for (int e = tid; e < 48 * 256 / 2; e += 512) ((unsigned*)z)[e] = 0u;
                bf16_t* z2 = KR + (size_t)(MP + s * SROW + PAST + DEC_SEQ) * 32;
                for (int e = tid; e < 48 * 32 / 2; e += 512) ((unsigned*)z2)[e] = 0u;
            }
        } else if (it >= 2048) mix_tile<16, true>(p, l, lds, tid, it - 2048, 0);
        else mix_tile<32, false>(p, l, lds, tid, it >> 6, (it & 63) * 32);
    }
}

template <int NQB>
__device__ __forceinline__ void attn_wave(const bf16_t* __restrict__ Q, const bf16_t* __restrict__ KN, const bf16_t* __restrict__ KRp, const bf16_t* __restrict__ VT,
                                          int kt0, int kstep, int ntiles, int nkeys, float* part, int lane) {
    const int fr = lane & 15, g = lane >> 4;
    bf16x8 qf[3][NQB];
#pragma unroll
    for (int ks = 0; ks < 3; ++ks)
#pragma unroll
        for (int nb = 0; nb < NQB; ++nb) qf[ks][nb] = *(const bf16x8*)(Q + (size_t)(nb * 16 + fr) * 768 + ks * 32 + g * 8);
    f32x4 o[4][NQB]; float mrun[NQB], lrun[NQB];
#pragma unroll
    for (int nb = 0; nb < NQB; ++nb) { mrun[nb] = -1e30f; lrun[nb] = 0.f;
#pragma unroll
        for (int df = 0; df < 4; ++df) o[df][nb] = (f32x4){0.f, 0.f, 0.f, 0.f}; }
    bf16x8 kc[4][3], kx[4][3];
#define ATT_LOADK(dst, kt_) do { const bf16_t* kn_ = KN + (size_t)(kt_) * 64 * 512; const bf16_t* kr_ = KRp + (size_t)(kt_) * 64 * 32; \
        _Pragma("unroll") for (int f = 0; f < 4; ++f) { dst[f][0] = *(const bf16x8*)(kn_ + (size_t)(f * 16 + fr) * 512 + g * 8); \
            dst[f][1] = *(const bf16x8*)(kn_ + (size_t)(f * 16 + fr) * 512 + 32 + g * 8); dst[f][2] = *(const bf16x8*)(kr_ + (size_t)(f * 16 + fr) * 32 + g * 8); } } while (0)
    ATT_LOADK(kc, kt0);
    for (int kt = kt0; kt < ntiles; kt += kstep) {
        const bf16_t* vt = VT + kt * 64;
        u32x2 vv[4][2][2];
#pragma unroll
        for (int df = 0; df < 4; ++df)
#pragma unroll
            for (int kk = 0; kk < 2; ++kk) { const bf16_t* vrow = vt + (size_t)(df * 16 + fr) * MA;
                vv[df][kk][0] = *(const u32x2*)(vrow + (2 * kk) * 16 + g * 4); vv[df][kk][1] = *(const u32x2*)(vrow + (2 * kk + 1) * 16 + g * 4); }
        { const int kn1 = (kt + kstep < ntiles) ? kt + kstep : kt; ATT_LOADK(kx, kn1); }
        f32x4 st[4][NQB];
#pragma unroll
        for (int f = 0; f < 4; ++f) {
#pragma unroll
            for (int nb = 0; nb < NQB; ++nb) {
                f32x4 c = {0.f, 0.f, 0.f, 0.f};
                c = __builtin_amdgcn_mfma_f32_16x16x32_bf16(kc[f][0], qf[0][nb], c, 0, 0, 0);
                c = __builtin_amdgcn_mfma_f32_16x16x32_bf16(kc[f][1], qf[1][nb], c, 0, 0, 0);
                c = __builtin_amdgcn_mfma_f32_16x16x32_bf16(kc[f][2], qf[2][nb], c, 0, 0, 0);
                st[f][nb] = c;
            }
        }
        if ((kt + 1) * 64 > nkeys) {
#pragma unroll
            for (int f = 0; f < 4; ++f)
#pragma unroll
                for (int r = 0; r < 4; ++r) if (kt * 64 + f * 16 + g * 4 + r >= nkeys) {
#pragma unroll
                    for (int nb = 0; nb < NQB; ++nb) st[f][nb][r] = -1e30f; }
        }
#pragma unroll
        for (int nb = 0; nb < NQB; ++nb) {
            float mx = -1e30f;
#pragma unroll
            for (int f = 0; f < 4; ++f)
#pragma unroll
                for (int r = 0; r < 4; ++r) mx = fmaxf(mx, st[f][nb][r]);
            mx = fmaxf(mx, shx(mx, 16, lane)); mx = fmaxf(mx, shx(mx, 32, lane));
            const float mn = fmaxf(mrun[nb], mx), al = __builtin_amdgcn_exp2f(mrun[nb] - mn); mrun[nb] = mn;
            float ps = 0.f;
#pragma unroll
            for (int f = 0; f < 4; ++f)
#pragma unroll
                for (int r = 0; r < 4; ++r) { const float e = __builtin_amdgcn_exp2f(st[f][nb][r] - mn); st[f][nb][r] = e; ps += e; }
            lrun[nb] = lrun[nb] * al + ps;
#pragma unroll
            for (int df = 0; df < 4; ++df) o[df][nb] *= al;
        }
#pragma unroll
        for (int kk = 0; kk < 2; ++kk) {
            bf16x8 pb[NQB];
#pragma unroll
            for (int nb = 0; nb < NQB; ++nb) {
                u32x4v t; t[0] = cvt_pk_bf16(st[2 * kk][nb][0], st[2 * kk][nb][1]); t[1] = cvt_pk_bf16(st[2 * kk][nb][2], st[2 * kk][nb][3]);
                t[2] = cvt_pk_bf16(st[2 * kk + 1][nb][0], st[2 * kk + 1][nb][1]); t[3] = cvt_pk_bf16(st[2 * kk + 1][nb][2], st[2 * kk + 1][nb][3]);
                pb[nb] = __builtin_bit_cast(bf16x8, t);
            }
#pragma unroll
            for (int df = 0; df < 4; ++df) {
                u32x4v t; const u32x2 v0 = vv[df][kk][0], v1 = vv[df][kk][1];
                t[0] = v0[0]; t[1] = v0[1]; t[2] = v1[0]; t[3] = v1[1];
                const bf16x8 a = __builtin_bit_cast(bf16x8, t);
#pragma unroll
                for (int nb = 0; nb < NQB; ++nb) o[df][nb] = __builtin_amdgcn_mfma_f32_16x16x32_bf16(a, pb[nb], o[df][nb], 0, 0, 0);
            }
        }
#pragma unroll
        for (int f = 0; f < 4; ++f)
#pragma unroll
            for (int k3 = 0; k3 < 3; ++k3) kc[f][k3] = kx[f][k3];
    }
#undef ATT_LOADK
    {
        float ls = lrun[0]; ls += shx(ls, 16, lane); ls += shx(ls, 32, lane);
#pragma unroll
        for (int df = 0; df < 4; ++df)
#pragma unroll
            for (int r = 0; r < 4; ++r) part[(df * 16 + g * 4 + r) * 16 + fr] = o[df][0][r];
        if (g == 0) { part[1024 + fr] = mrun[0]; part[1040 + fr] = ls; }
    }
}

__device__ void phase_attn(KP p, PG8_LAS unsigned char* lds, float* ldsf, int tid_in) {
    int tid_ = tid_in; asm volatile("" : "+v"(tid_));
    const int tid = tid_, wid = tid >> 6, lane = tid & 63, fr = lane & 15, g = lane >> 4;
    unsigned char* big = p->ws + OFF_BIG;
    const bf16_t* Q = (const bf16_t*)((const unsigned char*)p->out + D_Q); const bf16_t* KN = (const bf16_t*)((const unsigned char*)p->out + D_KN); const bf16_t* KR = (const bf16_t*)(big + B_KR);
    const bf16_t* VT = (const bf16_t*)(p->ws + OFF_VT); bf16_t* O = (bf16_t*)(big + B_O);
    for (int j = blockIdx.x; j < DEC_BATCH * N_HEADS; j += gridDim.x) {
        const int s = j >> 3, h = j & 7; const size_t kr0 = (size_t)MP + (size_t)s * SROW, qr0 = (size_t)MP + (size_t)s * DEC_SEQ;
        __syncthreads();
        attn_wave<1>(Q + qr0 * 768 + h * 96, KN + kr0 * 512 + h * 64, KR + kr0 * 32, VT + (size_t)(h * 64) * MA + kr0, wid, 8, 33, NPOS, ldsf + wid * 1056, lane);
        __syncthreads();
        for (int e = tid; e < 1024; e += 512) {
            const int d = e >> 4, q = e & 15;
            float mm = -1e30f;
#pragma unroll
            for (int w = 0; w < 8; ++w) mm = fmaxf(mm, ldsf[w * 1056 + 1024 + q]);
            float L = 0.f, Os = 0.f;
#pragma unroll
            for (int w = 0; w < 8; ++w) { const float sc = __builtin_amdgcn_exp2f(ldsf[w * 1056 + 1024 + q] - mm); L += ldsf[w * 1056 + 1040 + q] * sc; Os += ldsf[w * 1056 + e] * sc; }
            O[(qr0 + q) * 512 + h * 64 + d] = f2bf(Os / L);
        }
        __syncthreads();
    }
    constexpr int KS = 104, VS = 72, KB = 64 * KS * 2, VB = 64 * VS * 2, BUF = KB + VB;
    const bool lo = tid < 256;
    const int krow = tid >> 3, kch = (tid & 7) * 8;
    const int rrow = (tid & 255) >> 2, rch = (tid & 3) * 8;
    const int vdA = lo ? 32 + (tid >> 3) : (tid - 256) >> 3;
    const unsigned k_st = (unsigned)(krow * KS + kch) * 2u, r_st = (unsigned)(rrow * KS + 64 + rch) * 2u, v_st = (unsigned)KB + (unsigned)(vdA * VS + kch) * 2u;
    const unsigned ka_rd = (unsigned)(fr * KS + g * 8) * 2u, va_rd = (unsigned)KB + (unsigned)(fr * VS + g * 4) * 2u;
    for (int bh = blockIdx.x; bh < BATCH * N_HEADS; bh += gridDim.x) {
        const int b = bh >> 3, h = bh & 7; const size_t kr0 = (size_t)b * SEQ;
        const bf16_t* KNb = KN + kr0 * 512 + h * 64 + (size_t)krow * 512 + kch;
        const bf16_t* KRb = KR + kr0 * 32 + (size_t)rrow * 32 + rch;
        const bf16_t* VTb = VT + (size_t)(h * 64 + vdA) * MA + kr0 + kch;
        for (int qb = 7; qb >= 0; --qb) {
            const int qw = qb * 8 + (7 - wid), cw = qw >> 1, nt = 4 * qb + 4;
            const bf16_t* Qw = Q + (kr0 + (size_t)qw * 32) * 768 + h * 96;
            bf16x8 qf[3][2];
#pragma unroll
            for (int ks = 0; ks < 3; ++ks)
#pragma unroll
                for (int nb = 0; nb < 2; ++nb) qf[ks][nb] = *(const bf16x8*)(Qw + (size_t)(nb * 16 + fr) * 768 + ks * 32 + g * 8);
            f32x4 o[4][2]; float mrun[2], lrun[2];
#pragma unroll
            for (int nb = 0; nb < 2; ++nb) { mrun[nb] = -1e30f; lrun[nb] = 0.f;
#pragma unroll
                for (int df = 0; df < 4; ++df) o[df][nb] = (f32x4){0.f, 0.f, 0.f, 0.f}; }
            u32x4v r0, r1, r2;
#define AT_GLOAD(kt_) do { r0 = *(const u32x4v*)(KNb + (size_t)(kt_) * 64 * 512); \
                if (lo) { r1 = *(const u32x4v*)(KRb + (size_t)(kt_) * 64 * 32); r2 = *(const u32x4v*)(VTb + (kt_) * 64); } \
                else { r1 = *(const u32x4v*)(VTb + (kt_) * 64); } } while (0)
#define AT_LSTORE(bf_) do { PG8_LAS unsigned char* bb_ = lds + (bf_) * BUF; *(PG8_LAS u32x4v*)(bb_ + k_st) = r0; \
                if (lo) { *(PG8_LAS u32x4v*)(bb_ + r_st) = r1; *(PG8_LAS u32x4v*)(bb_ + v_st) = r2; } else { *(PG8_LAS u32x4v*)(bb_ + v_st) = r1; } } while (0)
            AT_GLOAD(0); AT_LSTORE(0); __syncthreads();
            for (int kt = 0; kt < nt; ++kt) {
                if (kt + 1 < nt) AT_GLOAD(kt + 1);
                if (kt <= cw) {
                    const PG8_LAS unsigned char* kb = lds + (kt & 1) * BUF;
                    f32x4 st[4][2];
#pragma unroll
                    for (int f = 0; f < 4; ++f) {
                        const bf16x8 a0 = *(const PG8_LAS bf16x8*)(kb + ka_rd + f * 16 * KS * 2);
                        const bf16x8 a1 = *(const PG8_LAS bf16x8*)(kb + ka_rd + f * 16 * KS * 2 + 64);
                        const bf16x8 a2 = *(const PG8_LAS bf16x8*)(kb + ka_rd + f * 16 * KS * 2 + 128);
#pragma unroll
                        for (int nb = 0; nb < 2; ++nb) {
                            f32x4 c = {0.f, 0.f, 0.f, 0.f};
                            c = __builtin_amdgcn_mfma_f32_16x16x32_bf16(a0, qf[0][nb], c, 0, 0, 0);
                            c = __builtin_amdgcn_mfma_f32_16x16x32_bf16(a1, qf[1][nb], c, 0, 0, 0);
                            c = __builtin_amdgcn_mfma_f32_16x16x32_bf16(a2, qf[2][nb], c, 0, 0, 0);
                            st[f][nb] = c;
                        }
                    }
#pragma unroll
                    for (int nb = 0; nb < 2; ++nb) {
                        float mx = -1e30f;
#pragma unroll
                        for (int f = 0; f < 4; ++f)
#pragma unroll
                            for (int r = 0; r < 4; ++r) mx = fmaxf(mx, st[f][nb][r]);
                        mx = fmaxf(mx, shx(mx, 16, lane)); mx = fmaxf(mx, shx(mx, 32, lane));
                        const float mn = fmaxf(mrun[nb], mx), al = __builtin_amdgcn_exp2f(mrun[nb] - mn); mrun[nb] = mn;
                        float ps = 0.f;
#pragma unroll
                        for (int f = 0; f < 4; ++f)
#pragma unroll
                            for (int r = 0; r < 4; ++r) { const float e = __builtin_amdgcn_exp2f(st[f][nb][r] - mn); st[f][nb][r] = e; ps += e; }
                        lrun[nb] = lrun[nb] * al + ps;
#pragma unroll
                        for (int df = 0; df < 4; ++df) o[df][nb] *= al;
                    }
#pragma unroll
                    for (int kk = 0; kk < 2; ++kk) {
                        bf16x8 pb[2];
#pragma unroll
                        for (int nb = 0; nb < 2; ++nb) {
                            u32x4v t; t[0] = cvt_pk_bf16(st[2 * kk][nb][0], st[2 * kk][nb][1]); t[1] = cvt_pk_bf16(st[2 * kk][nb][2], st[2 * kk][nb][3]);
                            t[2] = cvt_pk_bf16(st[2 * kk + 1][nb][0], st[2 * kk + 1][nb][1]); t[3] = cvt_pk_bf16(st[2 * kk + 1][nb][2], st[2 * kk + 1][nb][3]);
                            pb[nb] = __builtin_bit_cast(bf16x8, t);
                        }
#pragma unroll
                        for (int df = 0; df < 4; ++df) {
                            const u32x2 v0 = *(const PG8_LAS u32x2*)(kb + va_rd + df * 16 * VS * 2 + kk * 64), v1 = *(const PG8_LAS u32x2*)(kb + va_rd + df * 16 * VS * 2 + kk * 64 + 32);
                            u32x4v t; t[0] = v0[0]; t[1] = v0[1]; t[2] = v1[0]; t[3] = v1[1];
                            const bf16x8 a = __builtin_bit_cast(bf16x8, t);
#pragma unroll
                            for (int nb = 0; nb < 2; ++nb) o[df][nb] = __builtin_amdgcn_mfma_f32_16x16x32_bf16(a, pb[nb], o[df][nb], 0, 0, 0);
                        }
                    }
                }
                if (kt + 1 < nt) AT_LSTORE((kt + 1) & 1);
                __syncthreads();
            }
#undef AT_GLOAD
#undef AT_LSTORE
            bf16_t* Ow = O + (kr0 + (size_t)qw * 32) * 512 + h * 64;
#pragma unroll
            for (int nb = 0; nb < 2; ++nb) {
                float ls = lrun[nb]; ls += shx(ls, 16, lane); ls += shx(ls, 32, lane);
                const float inv = 1.f / ls;
#pragma unroll
                for (int df = 0; df < 4; ++df) {
                    u32x2 t; t[0] = cvt_pk_bf16(o[df][nb][0] * inv, o[df][nb][1] * inv); t[1] = cvt_pk_bf16(o[df][nb][2] * inv, o[df][nb][3] * inv);
                    *(u32x2*)(Ow + (size_t)(nb * 16 + fr) * 512 + df * 16 + g * 4) = t;
                }
            }
        }
    }
}

__device__ void phase_ln(KP p, const float* g, const float* b, bool final_out, int tid_in, int r0, int r1, int b0) {
    if ((int)blockIdx.x < b0) return;
    int tid_ = tid_in; asm volatile("" : "+v"(tid_));
    const int lane = tid_ & 63, gw = ((int)blockIdx.x - b0) * 8 + (tid_ >> 6), nw = ((int)gridDim.x - b0) * 8;
    bf16_t* Xb = (bf16_t*)(p->ws + OFF_XB);
    f32x4 gv[4], bv[4];
#pragma unroll
    for (int j = 0; j < 2; ++j)
#pragma unroll
        for (int q = 0; q < 2; ++q) { gv[2 * j + q] = *(const f32x4*)(g + lane * 8 + 512 * j + 4 * q); bv[2 * j + q] = *(const f32x4*)(b + lane * 8 + 512 * j + 4 * q); }
    for (int row = r0 + gw; row < r1; row += nw) {
        bf16_t* xr = Xb + (size_t)row * 1024 + lane * 8;
        f32x4 x[4]; float s = 0.f;
#pragma unroll
        for (int j = 0; j < 2; ++j) { const u32x4v u = *(const u32x4v*)(xr + 512 * j);
            x[2 * j] = (f32x4){bflo(u[0]), bfhi(u[0]), bflo(u[1]), bfhi(u[1])}; x[2 * j + 1] = (f32x4){bflo(u[2]), bfhi(u[2]), bflo(u[3]), bfhi(u[3])}; }
#pragma unroll
        for (int j = 0; j < 4; ++j) s += x[j][0] + x[j][1] + x[j][2] + x[j][3];
        const float mu = wave_sum(s, lane) * (1.f / 1024.f); float v = 0.f;
#pragma unroll
        for (int j = 0; j < 4; ++j) { x[j] = x[j] - mu; v += x[j][0] * x[j][0] + x[j][1] * x[j][1] + x[j][2] * x[j][2] + x[j][3] * x[j][3]; }
        const float r = rsqrtf(wave_sum(v, lane) * (1.f / 1024.f) + LN_EPS);
#pragma unroll
        for (int j = 0; j < 2; ++j) {
            const f32x4 y0 = x[2 * j] * r * gv[2 * j] + bv[2 * j], y1 = x[2 * j + 1] * r * gv[2 * j + 1] + bv[2 * j + 1];
            if (final_out) { float* yo = p->out + (size_t)row * 1024 + lane * 8 + 512 * j; *(f32x4*)yo = y0; *(f32x4*)(yo + 4) = y1; }
            else { u32x4v o; o[0] = cvt_pk_bf16(y0[0], y0[1]); o[1] = cvt_pk_bf16(y0[2], y0[3]); o[2] = cvt_pk_bf16(y1[0], y1[1]); o[3] = cvt_pk_bf16(y1[2], y1[3]);
                *(u32x4v*)(xr + 512 * j) = o; }
        }
    }
}
constexpr size_t OFF_BAR = WS_END;

#define XB_TMO      128
#define XB_XCNT(j)  (256  + 64 * (j))
#define XB_XSUB(j)  (1280 + 64 * (j))
#define XB_XGEN(j)  (2304 + 64 * (j))
#define XB_TOP      3328
#define XB_TOPGEN   3392
#define XCD_BAR_WORDS 3456
#define XB_SPIN_CAP (1u << 18)
__device__ __forceinline__ unsigned xb_ld(unsigned* p)              { return __hip_atomic_load(p, __ATOMIC_RELAXED, __HIP_MEMORY_SCOPE_AGENT); }
__device__ __forceinline__ unsigned xb_add(unsigned* p, unsigned v) { return __hip_atomic_fetch_add(p, v, __ATOMIC_RELAXED, __HIP_MEMORY_SCOPE_AGENT); }
__device__ __forceinline__ unsigned xb_xcc_id() { return (unsigned)__builtin_amdgcn_s_getreg((3 << 11) | 20) & 0xFu; }
#define XB_SPIN(cond, bar) do { unsigned _sp = 0; while (cond) { __builtin_amdgcn_s_sleep(1); \
    if ((++_sp & 255u) == 0u) { if (xb_ld(&(bar)[XB_TMO])) break; if (_sp > XB_SPIN_CAP) { atomicAdd(&(bar)[XB_TMO], 1u); break; } } } } while (0)
__device__ __forceinline__ void xcd_barrier_complete(unsigned* bar, unsigned x, unsigned& nloc, unsigned& nx) {
    const unsigned G = gridDim.x;
    unsigned sum, cnt, mine, sp = 0u;
    for (;;) {
        sum = 0u; cnt = 0u; mine = 0u;
#pragma unroll
        for (unsigned j = 0; j < 16; ++j) { const unsigned c = xb_ld(&bar[XB_XCNT(j)]); sum += c; cnt += (c > 0u) ? 1u : 0u; mine = (j == x) ? c : mine; }
        if (sum == G) break;
        __builtin_amdgcn_s_sleep(1);
        if ((++sp & 255u) == 0u) { if (xb_ld(&bar[XB_TMO])) break; if (sp > XB_SPIN_CAP) { atomicAdd(&bar[XB_TMO], 1u); break; } }
    }
    nloc = mine > 0u ? mine : 1u; nx = cnt > 0u ? cnt : 1u;
}
__device__ __forceinline__ void xcd_barrier(unsigned* bar, unsigned x, volatile PG8_LAS unsigned* st, int tid) {
    asm volatile("s_waitcnt vmcnt(0)" ::: "memory");
    __syncthreads();
    if (tid == 0) {
        __builtin_amdgcn_s_waitcnt(0);
        unsigned nloc = st[0], nx = st[1];
        if (nloc == 0u) { xcd_barrier_complete(bar, x, nloc, nx); st[0] = nloc; st[1] = nx; }
        const unsigned old = xb_add(&bar[XB_XSUB(x)], 1u);
        const unsigned gen = old / nloc;
        if (old + 1u == (gen + 1u) * nloc) {
            __builtin_amdgcn_fence(__ATOMIC_RELEASE, "agent");
            asm volatile("s_waitcnt vmcnt(0)" ::: "memory");
            const unsigned og = xb_add(&bar[XB_TOP], 1u);
            const unsigned tg = og / nx;
            if (og + 1u == (tg + 1u) * nx) xb_add(&bar[XB_TOPGEN], 1u);
            else XB_SPIN(xb_ld(&bar[XB_TOPGEN]) == tg, bar);
            __builtin_amdgcn_fence(__ATOMIC_ACQUIRE, "agent");
            xb_add(&bar[XB_XGEN(x)], 1u);
            asm volatile("s_waitcnt vmcnt(0)" ::: "memory");
        } else {
            XB_SPIN(xb_ld(&bar[XB_XGEN(x)]) == gen, bar);
            __builtin_amdgcn_fence(__ATOMIC_ACQUIRE, "agent");
            asm volatile("s_waitcnt vmcnt(0)" ::: "memory");
        }
    }
    __syncthreads();
}
__global__ void __launch_bounds__(512, 2) fwd_megakernel(Params p_unused) {
    extern __shared__ __attribute__((aligned(16))) unsigned char shm[];
    PG8_LAS unsigned char* lds = (PG8_LAS unsigned char*)shm;
    float* ldsf = (float*)shm;
    cg::grid_group grid = cg::this_grid();
    KP p = (KP)__builtin_amdgcn_kernarg_segment_ptr();
    const int wid_s = __builtin_amdgcn_readfirstlane((int)threadIdx.x >> 6);
    grid.sync();
    {
        volatile PG8_LAS unsigned* xst = (volatile PG8_LAS unsigned*)(lds + pg8::STAGE_BYTES);
        if (threadIdx.x == 0) { xst[0] = 0u; xst[1] = 0u; (void)xb_add(&((unsigned*)(p->ws + OFF_BAR))[XB_XCNT(xb_xcc_id())], 1u); }
        __syncthreads();
    }
#define TID() (wid_s * 64 + lane_id_v())
#define GSYNC() xcd_barrier((unsigned*)(p->ws + OFF_BAR), xb_xcc_id(), (volatile PG8_LAS unsigned*)(lds + pg8::STAGE_BYTES), TID())
    unsigned char* big = p->ws + OFF_BIG;
    unsigned char* dsc = (unsigned char*)p->out;
    bf16_t* Xb = (bf16_t*)(p->ws + OFF_XB);
    const float* rope = (const float*)(p->ws + OFF_ROPE);
    phase_prologue(p, ldsf, TID());
    GSYNC();
#pragma unroll 1
    for (int l = 0; l < DEPTH; ++l) {
        const bf16_t* W = (const bf16_t*)(p->ws + OFF_W) + (size_t)l * W_LAYER;
        { EpiPG e; e.P = (bf16_t*)(dsc + D_P); e.G3 = (bf16_t*)(big + B_G3); e.bias = p->in[I_BGATE] + (size_t)l * 3 * 1024; run_gemm(lds, TID(), Xb, W + WO_A, M, 5120, 1024, e); }
        GSYNC();
        phase_mixprep(p, l, ldsf, TID());
        GSYNC();
        { EpiQ e; e.O = (bf16_t*)(dsc + D_Q); e.rope = rope; run_gemm(lds, TID(), (const bf16_t*)(big + B_QN), W + WO_UQ, M, 768, 384, e); }
        { EpiB<0> e; e.O = (bf16_t*)(dsc + D_KN); e.ldc = 512; e.bias = nullptr; e.G = nullptr; e.ldg = 0; run_gemm(lds, TID(), (const bf16_t*)(big + B_CKV), W + WO_UK, MA, 512, 256, e, (gridDim.x == 256) ? 8 : 0); }
        { EpiB<0> e; e.O = (bf16_t*)(p->ws + OFF_VT); e.ldc = MA; e.bias = nullptr; e.G = nullptr; e.ldg = 0; run_gemm(lds, TID(), W + WO_UV, (const bf16_t*)(big + B_CKV), 512, MA, 256, e, (gridDim.x == 256) ? 16 : 0); }
        GSYNC();
        phase_attn(p, lds, ldsf, TID());
        GSYNC();
        {
            const bf16_t* G3 = (const bf16_t*)(big + B_G3); bf16_t* MG = (bf16_t*)(dsc + D_MG);
            { EpiB<3> e; e.O = MG; e.ldc = 1024; e.bias = nullptr; e.G = G3; e.ldg = 3072; run_gemm(lds, TID(), (const bf16_t*)(big + B_O), W + WO_MLA, M, 1024, 512, e); }
            { EpiB<4> e; e.O = MG; e.ldc = 1024; e.bias = nullptr; e.G = G3 + 1024; e.ldg = 3072; run_gemm(lds, TID(), (const bf16_t*)(big + B_CVN), W + WO_CONF, M, 1024, 256, e); }
            { EpiB<4> e; e.O = MG; e.ldc = 1024; e.bias = nullptr; e.G = G3 + 2048; e.ldg = 3072; run_gemm(lds, TID(), (const bf16_t*)(big + B_SCZ), W + WO_SC, M, 1024, 256, e); }
        }
        GSYNC();
#pragma unroll 1
        for (int part = 0; part < 2; ++part) {
            EpiB<5> e; e.O = part ? Xb + (size_t)MP * 1024 : Xb; e.ldc = 1024; e.bias = nullptr; e.G = nullptr; e.ldg = 0;
            run_gemm(lds, TID(), (const bf16_t*)(dsc + D_MG) + (part ? (size_t)MP * 1024 : 0), W + WO_MIX, part ? MS : MP, 1024, 1024, e);
            if (part == 0) GSYNC();
        }
#pragma unroll 1
        for (int part = 0; part < 2; ++part) {
            phase_ln(p, p->in[I_LN1G] + l * 1024, p->in[I_LN1B] + l * 1024, false, TID(), part ? MP : 0, part ? M : MP, part ? 0 : 4);
            GSYNC();
        }
        { EpiB<1> e; e.O = (bf16_t*)big; e.ldc = 4096; e.bias = p->in[I_BFF1] + (size_t)l * 4096; e.G = nullptr; e.ldg = 0; run_gemm(lds, TID(), Xb, W + WO_FF1, M, 4096, 1024, e); }
        GSYNC();
#pragma unroll 1
        for (int part = 0; part < 2; ++part) {
            EpiB<5> e; e.O = part ? Xb + (size_t)MP * 1024 : Xb; e.ldc = 1024; e.bias = p->in[I_BFF2] + l * 1024; e.G = nullptr; e.ldg = 0;
            run_gemm(lds, TID(), (const bf16_t*)big + (part ? (size_t)MP * 4096 : 0), W + WO_FF2, part ? MS : MP, 1024, 4096, e);
            if (part == 0) GSYNC();
        }
#pragma unroll 1
        for (int part = 0; part < 2; ++part) {
            phase_ln(p, p->in[I_LN2G] + l * 1024, p->in[I_LN2B] + l * 1024, l == DEPTH - 1, TID(), part ? MP : 0, part ? M : MP, part ? 0 : 4);
            if (part == 0 && l + 1 < DEPTH) convert_weights(p, ldsf, TID(), l + 1, 4);
            GSYNC();
        }
    }
}

extern "C" void kernel_launch(void* const* d_in, const int* in_sizes, int n_in, void* d_out, int out_size, void* d_ws, size_t ws_size, hipStream_t stream) {
    constexpr size_t kDynLds = pg8::STAGE_BYTES + 64;
    static int grid_blocks = 0;
    if (!grid_blocks) {
        hipFuncSetAttribute((const void*)fwd_megakernel, hipFuncAttributeMaxDynamicSharedMemorySize, (int)kDynLds);
        int dev = 0, cus = 0, per_cu = 0;
        hipGetDevice(&dev);
        hipDeviceGetAttribute(&cus, hipDeviceAttributeMultiprocessorCount, dev);
        hipOccupancyMaxActiveBlocksPerMultiprocessor(&per_cu, fwd_megakernel, 512, kDynLds);
        if (per_cu < 1) per_cu = 1;
        grid_blocks = cus * (per_cu > 1 ? 1 : per_cu);
    }
    if (ws_size < OFF_BAR + 16384) { fprintf(stderr, "workspace too small: %zu < %zu\n", ws_size, (size_t)WS_END); return; }
    Params p; memset(&p, 0, sizeof(p));
    for (int i = 0; i < 30; ++i) p.in[i] = (const float*)d_in[i];
    p.out = (float*)d_out; p.ws = (unsigned char*)d_ws;
    for (int i = 0; i < 16; ++i) p.inv[i] = powf(10000.0f, -(float)i / 16.0f);
    (void)hipMemsetAsync((unsigned char*)d_ws + OFF_BAR, 0, XCD_BAR_WORDS * 4, stream);
    void* args[] = {&p};
    hipError_t e = hipLaunchCooperativeKernel((const void*)fwd_megakernel, dim3(grid_blocks), dim3(512), args, kDynLds, stream);
    if (e != hipSuccess) fprintf(stderr, "cooperative launch failed: %s (grid %d)\n", hipGetErrorString(e), grid_blocks);
}
```

```cpp
#define USE_SIMPLE 0
#define GEMM_ALIGN true
#define GEMM_SP2 true
#include <hip/hip_runtime.h>
#include <hip/hip_cooperative_groups.h>
#include <cstdio>
#include <cmath>
#include <cstring>
namespace cg = cooperative_groups;
namespace pg8 {
#define PG8_LAS __attribute__((address_space(3)))
typedef unsigned short bf16_t;
typedef short bf16x8 __attribute__((ext_vector_type(8)));
typedef float f32x4 __attribute__((ext_vector_type(4)));
typedef unsigned u32x4 __attribute__((ext_vector_type(4)));
constexpr int BM = 256, BK = 64, HALF = 128, HTB = HALF * BK * 2  , STAGE_BYTES = 8 * HTB, NXCD = 8, WGM = 8;

__host__ __device__ __forceinline__ int lds_byte(int r, int c) { const int st = (r >> 4) * 2 + (c >> 5), rr = r & 15, cc = c & 31, ob = rr * 64 + cc * 2; return st * 1024 + (ob ^ (((ob >> 9) & 1) << 5)); }
__host__ __device__ __forceinline__ void stage_rc(int b, int& R, int& C) { const int st = b / 1024, sb = b % 1024, swz = sb ^ (((sb >> 9) & 1) << 5); R = (st >> 1) * 16 + swz / 64; C = (st & 1) * 32 + (swz % 64) / 2; }
__host__ __device__ __forceinline__ int perm32(int rho) { const int n = rho >> 4, i = rho & 15; return 8 * (i >> 2) + 4 * n + (i & 3); }

struct Unit { int pm, pn; };
struct Gemm { const bf16_t* A; const bf16_t* Bt; int M, N, K; };

struct StaticOrder {
    int nM, nN, nwg, G, c;
    __host__ __device__ void init(int M, int N, int G_, int c_) { nM = M / BM; nN = N / BM; nwg = nM * nN; G = G_; c = c_; }
    __host__ __device__ bool next(int i, Unit& u) const {
        const long L = (long)i * G + c; if (L >= nwg) return false;
        int wgid = (int)L; { const int q = nwg / NXCD, r = nwg % NXCD, xcd = wgid % NXCD, off = wgid / NXCD; wgid = (xcd < r ? xcd * (q + 1) : r * (q + 1) + (xcd - r) * q) + off; }
        const int nig = WGM * nN, gid = wgid / nig, fm = gid * WGM, gsz = (nM - fm) < WGM ? (nM - fm) : WGM;
        u.pm = fm + ((wgid % nig) % gsz); u.pn = (wgid % nig) / gsz; return true;
    }
    __device__ __forceinline__ void a_ready(const Unit&) const {}
    __device__ __forceinline__ void done(const Unit&) const {}
};
typedef float f32x2c __attribute__((ext_vector_type(2)));
typedef __bf16 bf16x2c __attribute__((ext_vector_type(2)));
__device__ __forceinline__ unsigned cvt_pk_bf16(float lo, float hi) { const f32x2c v = {lo, hi}; const bf16x2c b = __builtin_convertvector(v, bf16x2c); return __builtin_bit_cast(unsigned, b); }
template <class Epi, class Sched, bool ALIGN_EPI = false, bool SP2 = false>
__device__ __forceinline__ void gemm_phase(PG8_LAS unsigned char* lds, int tid_in, const Gemm g, const Sched& S, const Epi& E) {
    int tid_ = tid_in; asm volatile("" : "+v"(tid_));
    const int tid = tid_, wid = __builtin_amdgcn_readfirstlane(tid >> 6), lane = tid & 63, wr = wid >> 2, wc = wid & 3, fr = lane & 15, fq = lane >> 4;
    const int K = g.K, nt = K / BK;
    unsigned voffA[2], voffB[2];
#pragma unroll
    for (int i = 0; i < 2; ++i) { int R, C; stage_rc(tid * 16 + i * 8192, R, C); const int Rb = Epi::PERM ? ((R & ~31) + perm32(R & 31)) : R;
        voffA[i] = (unsigned)(R * K + C) * 2u; voffB[i] = (unsigned)(Rb * K + C) * 2u; }
    const size_t kstep = (size_t)(BK * 2);
    const size_t hstep = (size_t)HALF * K * 2;
    const size_t tstep = 2 * hstep;
    const unsigned ldsw = (unsigned)wid * 1024u;
    const int aoff = lds_byte(wr * 64 + fr, fq * 8), boff = lds_byte(wc * 32 + fr, fq * 8);
#define PG8_SA(b, h) (((b) * 2 + (h)) * HTB)
#define PG8_SB(b, h) ((4 + (b) * 2 + (h)) * HTB)
#define PG8_STAGE(bufoff, gbase, voff) do { _Pragma("unroll") for (int _i = 0; _i < 2; ++_i) \
        __builtin_amdgcn_global_load_lds((const unsigned*)((const char*)(gbase) + (voff)[_i]), (PG8_LAS unsigned*)(lds + (bufoff) + ldsw + _i * 8192), 16, 0, 0); } while (0)
#define PG8_LDA(dst, b, h) do { _Pragma("unroll") for (int m = 0; m < 4; ++m) _Pragma("unroll") for (int k = 0; k < 2; ++k) dst[m][k] = *(const PG8_LAS bf16x8*)(lds + PG8_SA(b, h) + aoff + m * 2048 + k * 1024); } while (0)
#define PG8_LDB(dst, b, h) do { _Pragma("unroll") for (int n = 0; n < 2; ++n) _Pragma("unroll") for (int k = 0; k < 2; ++k) dst[n][k] = *(const PG8_LAS bf16x8*)(lds + PG8_SB(b, h) + boff + n * 2048 + k * 1024); } while (0)
#define PG8_MMA(ai, bj, At, Bt) do { __builtin_amdgcn_s_setprio(1); _Pragma("unroll") for (int m = 0; m < 4; ++m) _Pragma("unroll") for (int n = 0; n < 2; ++n) _Pragma("unroll") for (int k = 0; k < 2; ++k) \
        acc[ai][bj][m][n] = __builtin_amdgcn_mfma_f32_16x16x32_bf16(Bt[n][k], At[m][k], acc[ai][bj][m][n], 0, 0, 0); __builtin_amdgcn_s_setprio(0); } while (0)
#define PG8_WAIT_V(n) asm volatile("s_waitcnt vmcnt(" #n ")" ::: "memory")
#define PG8_WAIT_L(n) asm volatile("s_waitcnt lgkmcnt(" #n ")" ::: "memory")
#define PG8_BAR __builtin_amdgcn_s_barrier()
#define PG8_SCHED __builtin_amdgcn_sched_barrier(0)
    Unit cur, nxt; int ui = 0;
    if (!S.next(0, cur)) return;
    f32x4 acc[2][2][4][2];
#pragma unroll
    for (int a = 0; a < 2; ++a)
#pragma unroll
        for (int b = 0; b < 2; ++b)
#pragma unroll
            for (int m = 0; m < 4; ++m)
#pragma unroll
                for (int n = 0; n < 2; ++n) acc[a][b][m][n] = (f32x4){0.f, 0.f, 0.f, 0.f};
    bf16x8 At[4][2], B0[2][2], B1[2][2];
    const char* cA = (const char*)g.A + (size_t)cur.pm * tstep; const char* cB = (const char*)g.Bt + (size_t)cur.pn * tstep;
    S.a_ready(cur);
    if constexpr (SP2) {
        PG8_STAGE(PG8_SB(0, 0), cB, voffB); PG8_STAGE(PG8_SB(0, 1), cB + hstep, voffB); PG8_STAGE(PG8_SA(0, 0), cA, voffA); PG8_STAGE(PG8_SA(0, 1), cA + hstep, voffA);
        if (wr == 1) PG8_BAR;
        PG8_WAIT_V(2); PG8_BAR;
        PG8_STAGE(PG8_SB(1, 0), cB + kstep, voffB); PG8_STAGE(PG8_SA(1, 0), cA + kstep, voffA); PG8_STAGE(PG8_SB(1, 1), cB + hstep + kstep, voffB);
        PG8_WAIT_V(6); PG8_BAR;
    } else {
        PG8_STAGE(PG8_SB(0, 0), cB, voffB); PG8_STAGE(PG8_SA(0, 0), cA, voffA); PG8_STAGE(PG8_SB(0, 1), cB + hstep, voffB); PG8_STAGE(PG8_SA(0, 1), cA + hstep, voffA);
        if (wr == 1) PG8_BAR;
        PG8_WAIT_V(4); PG8_BAR;
        PG8_STAGE(PG8_SB(1, 0), cB + kstep, voffB); PG8_STAGE(PG8_SA(1, 0), cA + kstep, voffA); PG8_STAGE(PG8_SB(1, 1), cB + hstep + kstep, voffB);
        PG8_WAIT_V(6); PG8_BAR;
    }
    for (;;) {
        const bool has_next = S.next(ui + 1, nxt);
        const char* nA = has_next ? (const char*)g.A + (size_t)nxt.pm * tstep : cA; const char* nB = has_next ? (const char*)g.Bt + (size_t)nxt.pn * tstep : cB;
        for (int t = 0; t < nt; t += 2) {
            const bool last = (t == nt - 2);
            const char* a1 = cA + (size_t)(t + 1) * kstep;
            const char* a2 = last ? nA : cA + (size_t)(t + 2) * kstep; const char* b2 = last ? nB : cB + (size_t)(t + 2) * kstep;
            const char* a3 = a2 + kstep; const char* b3 = b2 + kstep;
            if (last && has_next) S.a_ready(nxt);
            if constexpr (SP2) {
            PG8_LDB(B0, 0, 0); PG8_LDB(B1, 0, 1); PG8_SCHED; PG8_LDA(At, 0, 0); PG8_STAGE(PG8_SA(1, 1), a1 + hstep, voffA);
            PG8_WAIT_V(8); PG8_WAIT_L(0); PG8_BAR; PG8_MMA(0, 0, At, B0); PG8_MMA(0, 1, At, B1); PG8_BAR; PG8_SCHED;
            PG8_LDA(At, 0, 1); PG8_STAGE(PG8_SB(0, 0), b2, voffB); PG8_STAGE(PG8_SB(0, 1), b2 + hstep, voffB); PG8_STAGE(PG8_SA(0, 0), a2, voffA);
            PG8_WAIT_V(8); PG8_WAIT_L(0); PG8_BAR; PG8_MMA(1, 0, At, B0); PG8_MMA(1, 1, At, B1); PG8_BAR; PG8_SCHED;
            PG8_LDB(B0, 1, 0); PG8_LDB(B1, 1, 1); PG8_SCHED; PG8_LDA(At, 1, 0); PG8_STAGE(PG8_SA(0, 1), a2 + hstep, voffA);
            PG8_WAIT_V(8); PG8_WAIT_L(0); PG8_BAR; PG8_MMA(0, 0, At, B0); PG8_MMA(0, 1, At, B1); PG8_BAR; PG8_SCHED;
            PG8_LDA(At, 1, 1); PG8_STAGE(PG8_SB(1, 0), b3, voffB); PG8_STAGE(PG8_SB(1, 1), b3 + hstep, voffB); PG8_STAGE(PG8_SA(1, 0), a3, voffA);
            PG8_WAIT_V(8); PG8_WAIT_L(0); PG8_BAR; PG8_MMA(1, 0, At, B0); PG8_MMA(1, 1, At, B1); PG8_BAR; PG8_SCHED;
            } else {
            PG8_LDB(B0, 0, 0); PG8_SCHED; PG8_LDA(At, 0, 0); PG8_STAGE(PG8_SA(1, 1), a1 + hstep, voffA);
            PG8_WAIT_L(8); PG8_BAR; PG8_WAIT_L(0); PG8_MMA(0, 0, At, B0); PG8_BAR; PG8_SCHED;
            PG8_LDB(B1, 0, 1); PG8_STAGE(PG8_SB(0, 0), b2, voffB);
            PG8_BAR; PG8_WAIT_L(0); PG8_MMA(0, 1, At, B1); PG8_BAR;
            PG8_LDA(At, 0, 1); PG8_STAGE(PG8_SA(0, 0), a2, voffA);
            PG8_BAR; PG8_WAIT_L(0); PG8_MMA(1, 0, At, B0); PG8_BAR; PG8_SCHED;
            PG8_STAGE(PG8_SB(0, 1), b2 + hstep, voffB);
            PG8_WAIT_V(6); PG8_BAR; PG8_MMA(1, 1, At, B1); PG8_BAR;
            PG8_LDB(B0, 1, 0); PG8_SCHED; PG8_LDA(At, 1, 0); PG8_STAGE(PG8_SA(0, 1), a2 + hstep, voffA);
            PG8_WAIT_L(8); PG8_BAR; PG8_WAIT_L(0); PG8_MMA(0, 0, At, B0); PG8_BAR; PG8_SCHED;
            PG8_LDB(B1, 1, 1); PG8_STAGE(PG8_SB(1, 0), b3, voffB);
            PG8_BAR; PG8_WAIT_L(0); PG8_MMA(0, 1, At, B1); PG8_BAR;
            PG8_LDA(At, 1, 1); PG8_STAGE(PG8_SA(1, 0), a3, voffA);
            PG8_BAR; PG8_WAIT_L(0); PG8_MMA(1, 0, At, B0); PG8_BAR; PG8_SCHED;
            PG8_STAGE(PG8_SB(1, 1), b3 + hstep, voffB);
            PG8_WAIT_V(6); PG8_BAR; PG8_MMA(1, 1, At, B1); PG8_BAR;
            }
        }
        if constexpr (ALIGN_EPI) { if (wr == 0) PG8_BAR; }
        if constexpr (!Epi::AFTER_DRAIN) { E(acc, cur, wr, wc, fr, fq); S.done(cur); }
        if (!has_next) break;
#pragma unroll
        for (int a = 0; a < 2; ++a)
#pragma unroll
            for (int b = 0; b < 2; ++b)
#pragma unroll
                for (int m = 0; m < 4; ++m)
#pragma unroll
                    for (int n = 0; n < 2; ++n) acc[a][b][m][n] = (f32x4){0.f, 0.f, 0.f, 0.f};
        cur = nxt; cA = nA; cB = nB; ++ui;
        if constexpr (ALIGN_EPI) { if (wr == 1) PG8_BAR; }
    }
    PG8_WAIT_V(0);
    if constexpr (!ALIGN_EPI) { if (wr == 0) PG8_BAR; }
    PG8_BAR;
    if constexpr (Epi::AFTER_DRAIN) { E.fused(acc, cur, wr, wc, fr, fq, lds, wid, lane); S.done(cur); }
#undef PG8_SA
#undef PG8_SB
#undef PG8_STAGE
#undef PG8_LDA
#undef PG8_LDB
#undef PG8_MMA
#undef PG8_WAIT_V
#undef PG8_WAIT_L
#undef PG8_BAR
#undef PG8_SCHED
}
}
using pg8::bf16_t; using pg8::bf16x8; using pg8::f32x4; using pg8::Unit; using pg8::cvt_pk_bf16;
typedef short bf16x4 __attribute__((ext_vector_type(4)));
typedef unsigned u32x2 __attribute__((ext_vector_type(2)));
typedef unsigned u32x4v __attribute__((ext_vector_type(4)));

constexpr int D_MODEL = 1024, BATCH = 32, SEQ = 2048, DEPTH = 4, DEC_BATCH = 16, DEC_SEQ = 16, PAST = 2048;
constexpr int N_HEADS = 8, Q_LORA = 384, KV_LORA = 256, ROPE_D = 32, CONF_CH = 256, SC_CH = 256, D_FF = 4096, N_IN = 5024;
constexpr int MP = BATCH * SEQ;
constexpr int MS = DEC_BATCH * DEC_SEQ;
constexpr int M = MP + MS;
constexpr int SROW = 2112;
constexpr int MA = MP + DEC_BATCH * SROW;
constexpr int NPOS = PAST + DEC_SEQ;
constexpr int PW = 2048;
constexpr float DN_ALPHA = 1.681792830507429f;
constexpr float LN_EPS = 1e-5f, RMS_EPS = 1e-6f;
constexpr float QSCALE = 0.10206207261596577f * 1.4426950408889634f;
constexpr int PC_Q = 0, PC_KV = 384, PC_KR = 640, PC_CA = 672, PC_CG = 928, PC_GB = 1184, PC_GC = 1440, PC_H = 1696;

constexpr size_t WO_A = 0, WO_G = 2097152, WO_UQ = 5242880, WO_UK = 5537792, WO_UV = 5668864, WO_MLA = 5799936, WO_CONF = 6324224, WO_SC = 6586368,
                 WO_MIX = 6848512, WO_FF1 = 7897088, WO_FF2 = 12091392, W_LAYER = 16285696;
constexpr size_t OFF_W = 0, OFF_ROPE = W_LAYER * 2 * DEPTH, OFF_XB = OFF_ROPE + (size_t)NPOS * 32 * 4, OFF_BIG = OFF_XB + (size_t)M * 1024 * 2,
                 G3SZ = (size_t)M * 3072 * 2;
constexpr size_t B_G3 = 0, B_QN = G3SZ, B_CKV = B_QN + (size_t)M * 384 * 2, B_KR = B_CKV + (size_t)MA * 256 * 2, B_CVN = B_KR + (size_t)MA * 32 * 2,
                 B_SCZ = B_CVN + (size_t)M * 256 * 2, B_O = B_SCZ + (size_t)M * 256 * 2, B_END = B_O + (size_t)M * 512 * 2;
constexpr size_t BIGSZ = B_END > (size_t)M * 4096 * 2 ? B_END : (size_t)M * 4096 * 2;
constexpr size_t OFF_VT = OFF_BIG + BIGSZ, WS_END = OFF_VT + (size_t)512 * MA * 2;
constexpr size_t D_P = 0, D_Q = 0, D_KN = (size_t)M * 768 * 2, D_MG = 0;
static_assert(D_KN + (size_t)MA * 512 * 2 <= (size_t)M * 1024 * 4, "d_out scratch overflow");
static_assert((size_t)M * PW * 2 <= (size_t)M * 1024 * 4, "P overflow");
constexpr size_t OO_Y = 0, OO_CKVP = (size_t)M * 1024, OO_KRP = OO_CKVP + (size_t)DEPTH * MP * 256, OO_CONFP = OO_KRP + (size_t)DEPTH * MP * 32,
                 OO_SCP = OO_CONFP + (size_t)DEPTH * BATCH * 30 * 256, OO_CKVS = OO_SCP + (size_t)DEPTH * BATCH * 2 * 256, OO_KRS = OO_CKVS + (size_t)DEPTH * MS * 256,
                 OO_CONFS = OO_KRS + (size_t)DEPTH * MS * 32, OO_SCS = OO_CONFS + (size_t)DEPTH * DEC_BATCH * 30 * 256, OO_END = OO_SCS + (size_t)DEPTH * DEC_BATCH * 2 * 256;

struct Params {
    const float* in[30];
    float* out; unsigned char* ws;
    float inv[16];
};
typedef const Params __attribute__((address_space(4)))* KP;
enum { I_XP = 0, I_XS, I_CCKV, I_CKR, I_SCONF, I_SSC, I_WIN, I_BGATE, I_QNG, I_WUQ, I_KVNG, I_WUK, I_WUV, I_WMLA, I_CDW, I_CDB, I_CLG, I_CLB, I_WCONF, I_SDW, I_WSC, I_WMIX,
       I_LN1G, I_LN1B, I_WFF1, I_BFF1, I_WFF2, I_BFF2, I_LN2G, I_LN2B };

__device__ __forceinline__ float bf2f(bf16_t b) { return __uint_as_float(((unsigned)b) << 16); }
__device__ __forceinline__ float bflo(unsigned u) { return __uint_as_float(u << 16); }
__device__ __forceinline__ float bfhi(unsigned u) { return __uint_as_float(u & 0xffff0000u); }
__device__ __forceinline__ bf16_t f2bf(float f) { return (bf16_t)(cvt_pk_bf16(f, 0.f) & 0xffffu); }
__device__ __forceinline__ float sigmoidf_(float x) { return __builtin_amdgcn_rcpf(1.f + __builtin_amdgcn_exp2f(-1.4426950408889634f * x)); }
__device__ __forceinline__ float shx(float v, int o, int lane) { return __int_as_float(__builtin_amdgcn_ds_bpermute((lane ^ o) << 2, __float_as_int(v))); }
__device__ __forceinline__ float wave_sum(float v, int lane) {
#pragma unroll
    for (int o = 32; o > 0; o >>= 1) v += shx(v, o, lane);
    return v;
}

__device__ __forceinline__ int lane_id_v() { int l; asm volatile("v_mbcnt_lo_u32_b32 %0, -1, 0\n\tv_mbcnt_hi_u32_b32 %0, -1, %0" : "=v"(l)); return l; }
template <int MODE> struct EpiB {
    static constexpr bool PERM = true, AFTER_DRAIN = false;
    bf16_t* O; int ldc; const float* bias; const bf16_t* G; int ldg;
    __device__ __forceinline__ void operator()(const f32x4 (&acc)[2][2][4][2], const Unit& u, int wr, int wc, int fr_, int fq_) const {
        const int lane_ = lane_id_v(), fr = lane_ & 15, fq = lane_ >> 4;
        const int row0 = u.pm * 256 + wr * 64 + fr, col0 = u.pn * 256 + wc * 32 + 8 * fq;
        f32x4 bv[2][2];
#pragma unroll
        for (int bj = 0; bj < 2; ++bj)
#pragma unroll
            for (int n = 0; n < 2; ++n) bv[bj][n] = (MODE == 1 || MODE == 2 || (MODE == 5 && bias != nullptr)) ? *(const f32x4*)(bias + col0 + bj * 128 + 4 * n) : (f32x4){0.f, 0.f, 0.f, 0.f};
#pragma unroll
        for (int ai = 0; ai < 2; ++ai) {
            u32x4v gq[4][2], pq[4][2];
            if (MODE >= 3) {
#pragma unroll
                for (int m = 0; m < 4; ++m)
#pragma unroll
                    for (int bj = 0; bj < 2; ++bj) {
                        const size_t rowi = (size_t)(row0 + ai * 128 + m * 16);
                        if (MODE == 3 || MODE == 4) gq[m][bj] = *(const u32x4v*)(G + rowi * ldg + col0 + bj * 128);
                        if (MODE == 4 || MODE == 5) pq[m][bj] = *(const u32x4v*)(O + rowi * ldc + col0 + bj * 128);
                    }
            }
#pragma unroll
            for (int m = 0; m < 4; ++m) {
                const size_t ro = (size_t)(row0 + ai * 128 + m * 16) * ldc + col0;
#pragma unroll
                for (int bj = 0; bj < 2; ++bj) {
                    f32x4 v0 = acc[ai][bj][m][0] + bv[bj][0], v1 = acc[ai][bj][m][1] + bv[bj][1];
                    if (MODE == 1) {
#pragma unroll
                        for (int j = 0; j < 4; ++j) { float a = fmaxf(v0[j], 0.f), b = fmaxf(v1[j], 0.f); v0[j] = a * a; v1[j] = b * b; }
                    } else if (MODE == 2) {
#pragma unroll
                        for (int j = 0; j < 4; ++j) { v0[j] = sigmoidf_(v0[j]); v1[j] = sigmoidf_(v1[j]); }
                    } else if (MODE == 5) {
                        const u32x4v pp = pq[m][bj];
                        v0[0] += DN_ALPHA * bflo(pp[0]); v0[1] += DN_ALPHA * bfhi(pp[0]); v0[2] += DN_ALPHA * bflo(pp[1]); v0[3] += DN_ALPHA * bfhi(pp[1]);
                        v1[0] += DN_ALPHA * bflo(pp[2]); v1[1] += DN_ALPHA * bfhi(pp[2]); v1[2] += DN_ALPHA * bflo(pp[3]); v1[3] += DN_ALPHA * bfhi(pp[3]);
                    } else if (MODE == 3 || MODE == 4) {
                        const u32x4v gg = gq[m][bj];
                        v0[0] *= bflo(gg[0]); v0[1] *= bfhi(gg[0]); v0[2] *= bflo(gg[1]); v0[3] *= bfhi(gg[1]);
                        v1[0] *= bflo(gg[2]); v1[1] *= bfhi(gg[2]); v1[2] *= bflo(gg[3]); v1[3] *= bfhi(gg[3]);
                        if (MODE == 4) {
                            const u32x4v pp = pq[m][bj];
                            v0[0] += bflo(pp[0]); v0[1] += bfhi(pp[0]); v0[2] += bflo(pp[1]); v0[3] += bfhi(pp[1]);
                            v1[0] += bflo(pp[2]); v1[1] += bfhi(pp[2]); v1[2] += bflo(pp[3]); v1[3] += bfhi(pp[3]);
                        }
                    }
                    u32x4v o; o[0] = cvt_pk_bf16(v0[0], v0[1]); o[1] = cvt_pk_bf16(v0[2], v0[3]); o[2] = cvt_pk_bf16(v1[0], v1[1]); o[3] = cvt_pk_bf16(v1[2], v1[3]);
                    if (MODE == 1) __builtin_nontemporal_store(o, (u32x4v*)(O + ro + bj * 128));
                    else *(u32x4v*)(O + ro + bj * 128) = o;
                }
            }
        }
    }
};
struct EpiPG {
    static constexpr bool PERM = true, AFTER_DRAIN = false;
    bf16_t* P; bf16_t* G3; const float* bias;
    __device__ __forceinline__ void operator()(const f32x4 (&acc)[2][2][4][2], const Unit& u, int wr, int wc, int fr, int fq) const {
        if (u.pn < 8) { EpiB<0> e; e.O = P; e.ldc = PW; e.bias = nullptr; e.G = nullptr; e.ldg = 0; e(acc, u, wr, wc, fr, fq); }
        else { EpiB<2> e; e.O = G3; e.ldc = 3072; e.bias = bias; e.G = nullptr; e.ldg = 0; Unit u2; u2.pm = u.pm; u2.pn = u.pn - 8; e(acc, u2, wr, wc, fr, fq); }
    }
};
__device__ __forceinline__ int row_pos(int row) { return row < MP ? (row & (SEQ - 1)) : PAST + ((row - MP) & (DEC_SEQ - 1)); }
struct EpiQ {
    static constexpr bool PERM = false, AFTER_DRAIN = false;
    bf16_t* O; const float* rope;
    __device__ __forceinline__ void operator()(const f32x4 (&acc)[2][2][4][2], const Unit& u, int wr, int wc, int fr_, int fq_) const {
        const int lane_ = lane_id_v(), fr = lane_ & 15, fq = lane_ >> 4;
        const int row0 = u.pm * 256 + wr * 64 + fr, col0 = u.pn * 256 + wc * 32 + 4 * fq;
#pragma unroll
        for (int ai = 0; ai < 2; ++ai) {
            f32x4 csv[4], snv[4];
#pragma unroll
            for (int m = 0; m < 4; ++m) { const float* rp = rope + (size_t)row_pos(row0 + ai * 128 + m * 16) * 32 + 4 * fq; csv[m] = *(const f32x4*)rp; snv[m] = *(const f32x4*)(rp + 16); }
#pragma unroll
            for (int m = 0; m < 4; ++m) {
                const int row = row0 + ai * 128 + m * 16;
                const f32x4 cs = csv[m], sn = snv[m];
#pragma unroll
                for (int bj = 0; bj < 2; ++bj) {
                    const int grp = u.pn * 8 + bj * 4 + wc;
                    f32x4 v0 = acc[ai][bj][m][0], v1 = acc[ai][bj][m][1];
                    if (grp % 3 == 2) { const f32x4 a = v0 * cs - v1 * sn, b = v0 * sn + v1 * cs; v0 = a; v1 = b; }
                    v0 *= QSCALE; v1 *= QSCALE;
                    bf16_t* p = O + (size_t)row * 768 + col0 + bj * 128;
                    u32x2 o0, o1; o0[0] = cvt_pk_bf16(v0[0], v0[1]); o0[1] = cvt_pk_bf16(v0[2], v0[3]); o1[0] = cvt_pk_bf16(v1[0], v1[1]); o1[1] = cvt_pk_bf16(v1[2], v1[3]);
                    *(u32x2*)p = o0; *(u32x2*)(p + 16) = o1;
                }
            }
        }
    }
};
template <bool BIAS> struct EpiRes {
    static constexpr bool PERM = false, AFTER_DRAIN = false;
    float* X; const float* bias;
    __device__ __forceinline__ void operator()(const f32x4 (&acc)[2][2][4][2], const Unit& u, int wr, int wc, int fr_, int fq_) const {
        const int lane_ = lane_id_v(), fr = lane_ & 15, fq = lane_ >> 4;
        const int row0 = u.pm * 256 + wr * 64 + fr, col0 = u.pn * 256 + wc * 32 + 4 * fq;
        f32x4 bv[2][2];
#pragma unroll
        for (int bj = 0; bj < 2; ++bj)
#pragma unroll
            for (int n = 0; n < 2; ++n) bv[bj][n] = BIAS ? *(const f32x4*)(bias + col0 + bj * 128 + n * 16) : (f32x4){0.f, 0.f, 0.f, 0.f};
#pragma unroll
        for (int ai = 0; ai < 2; ++ai)
#pragma unroll
            for (int m = 0; m < 4; ++m) {
                float* rowp = X + (size_t)(row0 + ai * 128 + m * 16) * 1024 + col0;
#pragma unroll
                for (int bj = 0; bj < 2; ++bj)
#pragma unroll
                    for (int n = 0; n < 2; ++n) { f32x4* p = (f32x4*)(rowp + bj * 128 + n * 16); *p = *p * DN_ALPHA + acc[ai][bj][m][n] + bv[bj][n]; }
            }
    }
};

#ifndef USE_SIMPLE
#define USE_SIMPLE 1
#endif
template <class Epi>
__device__ __forceinline__ void gemm_simple(PG8_LAS unsigned char* lds, int tid_in, const bf16_t* __restrict__ A, const bf16_t* __restrict__ Bt, int Mr, int N, int K, const Epi& E) {
    using namespace pg8;
    int tid_ = tid_in; asm volatile("" : "+v"(tid_));
    const int tid = tid_, wid = tid >> 6, lane = tid & 63, wr = wid >> 2, wc = wid & 3, fr = lane & 15, fq = lane >> 4;
    const int nt = K / 64;
    const int aoff = lds_byte(wr * 64 + fr, fq * 8), boff = lds_byte(wc * 32 + fr, fq * 8);
    int sl[2]; size_t ga[2], gb[2];
#pragma unroll
    for (int i = 0; i < 2; ++i) { const int q = tid + i * 512, r = q >> 3, c8 = (q & 7) * 8, rb = Epi::PERM ? ((r & ~31) + perm32(r & 31)) : r;
        sl[i] = lds_byte(r, c8); ga[i] = (size_t)r * K + c8; gb[i] = (size_t)rb * K + c8; }
    StaticOrder S; S.init(Mr, N, (int)gridDim.x, (int)blockIdx.x);
    Unit un;
    for (int ui = 0; S.next(ui, un); ++ui) {
        f32x4 acc[2][2][4][2];
#pragma unroll
        for (int a = 0; a < 2; ++a)
#pragma unroll
            for (int b = 0; b < 2; ++b)
#pragma unroll
                for (int m = 0; m < 4; ++m)
#pragma unroll
                    for (int n = 0; n < 2; ++n) acc[a][b][m][n] = (f32x4){0.f, 0.f, 0.f, 0.f};
        const bf16_t* Ab = A + (size_t)un.pm * 256 * K; const bf16_t* Bb = Bt + (size_t)un.pn * 256 * K;
        u32x4v ra[2][2], rb[2][2];
#define SG_GLOAD(kt) do { _Pragma("unroll") for (int h = 0; h < 2; ++h) _Pragma("unroll") for (int i = 0; i < 2; ++i) { \
            ra[h][i] = *(const u32x4v*)(Ab + (size_t)h * 128 * K + ga[i] + (kt) * 64); rb[h][i] = *(const u32x4v*)(Bb + (size_t)h * 128 * K + gb[i] + (kt) * 64); } } while (0)
#define SG_LSTORE(b) do { _Pragma("unroll") for (int h = 0; h < 2; ++h) _Pragma("unroll") for (int i = 0; i < 2; ++i) { \
            *(PG8_LAS u32x4v*)(lds + ((b) * 4 + h) * HTB + sl[i]) = ra[h][i]; *(PG8_LAS u32x4v*)(lds + ((b) * 4 + 2 + h) * HTB + sl[i]) = rb[h][i]; } } while (0)
        SG_GLOAD(0); SG_LSTORE(0); __syncthreads();
        for (int kt = 0; kt < nt; ++kt) {
            const int b = kt & 1;
            if (kt + 1 < nt) SG_GLOAD(kt + 1);
#pragma unroll
            for (int ai = 0; ai < 2; ++ai) {
                bf16x8 At[4][2];
#pragma unroll
                for (int m = 0; m < 4; ++m)
#pragma unroll
                    for (int k = 0; k < 2; ++k) At[m][k] = *(const PG8_LAS bf16x8*)(lds + (b * 4 + ai) * HTB + aoff + m * 2048 + k * 1024);
#pragma unroll
                for (int bj = 0; bj < 2; ++bj) {
                    bf16x8 Bf[2][2];
#pragma unroll
                    for (int n = 0; n < 2; ++n)
#pragma unroll
                        for (int k = 0; k < 2; ++k) Bf[n][k] = *(const PG8_LAS bf16x8*)(lds + (b * 4 + 2 + bj) * HTB + boff + n * 2048 + k * 1024);
#pragma unroll
                    for (int m = 0; m < 4; ++m)
#pragma unroll
                        for (int n = 0; n < 2; ++n)
#pragma unroll
                            for (int k = 0; k < 2; ++k) acc[ai][bj][m][n] = __builtin_amdgcn_mfma_f32_16x16x32_bf16(Bf[n][k], At[m][k], acc[ai][bj][m][n], 0, 0, 0);
                }
            }
            if (kt + 1 < nt) SG_LSTORE(b ^ 1);
            __syncthreads();
        }
#undef SG_GLOAD
#undef SG_LSTORE
        E(acc, un, wr, wc, fr, fq);
    }
}

template <class Epi> __device__ __forceinline__ void run_gemm(PG8_LAS unsigned char* lds, int tid, const bf16_t* A, const bf16_t* Bt, int Mr, int N, int K, const Epi& E) {
#if USE_SIMPLE
    gemm_simple<Epi>(lds, tid, A, Bt, Mr, N, K, E);
#else
    pg8::Gemm g; g.A = A; g.Bt = Bt; g.M = Mr; g.N = N; g.K = K;
    pg8::StaticOrder S; S.init(Mr, N, (int)gridDim.x, (int)blockIdx.x);
    pg8::gemm_phase<Epi, pg8::StaticOrder, GEMM_ALIGN, GEMM_SP2>(lds, tid, g, S, E);
#endif
}
struct TJob { int in_idx, K, Nd, Nvalid, ld, coloff; size_t dst; int tiles; };
__device__ __forceinline__ TJob tjob(int j) {
    switch (j) {
        case 0: return {I_WIN, 1024, 2048, 1952, N_IN, 0, WO_A, 512};
        case 1: return {I_WIN, 1024, 3072, 3072, N_IN, 1952, WO_G, 768};
        case 2: return {I_WUQ, 384, 768, 768, 768, 0, WO_UQ, 72};
        case 3: return {I_WUK, 256, 512, 512, 512, 0, WO_UK, 32};
        case 4: return {I_WUV, 256, 512, 512, 512, 0, WO_UV, 32};
        case 5: return {I_WMLA, 512, 1024, 1024, 1024, 0, WO_MLA, 128};
        case 6: return {I_WCONF, 256, 1024, 1024, 1024, 0, WO_CONF, 64};
        case 7: return {I_WSC, 256, 1024, 1024, 1024, 0, WO_SC, 64};
        case 8: return {I_WMIX, 1024, 1024, 1024, 1024, 0, WO_MIX, 256};
        case 9: return {I_WFF1, 1024, 4096, 4096, 4096, 0, WO_FF1, 1024};
        default: return {I_WFF2, 4096, 1024, 1024, 1024, 0, WO_FF2, 1024};
    }
}
constexpr int TILES_PER_LAYER = 512 + 768 + 72 + 32 + 32 + 128 + 64 + 64 + 256 + 1024 + 1024;

__device__ __forceinline__ void convert_weights(KP p, float* lds, int tid_in, int l, int b0) {
    if ((int)blockIdx.x < b0) return;
    int tid = tid_in; asm volatile("" : "+v"(tid));
    bf16_t* W = (bf16_t*)(p->ws + OFF_W);
    for (int t = (int)blockIdx.x - b0; t < TILES_PER_LAYER; t += (int)gridDim.x - b0) {
        int r = t; int j = 0; TJob jb = tjob(0);
        while (r >= jb.tiles) { r -= jb.tiles; ++j; jb = tjob(j); }
        const int nk = jb.K / 64, kt = r % nk, ntile = r / nk, k0 = kt * 64, n0 = ntile * 64;
        const float* src = p->in[jb.in_idx] + (size_t)l * jb.K * jb.ld + jb.coloff;
        __syncthreads();
#pragma unroll
        for (int i = 0; i < 8; ++i) {
            const int e = tid + i * 512, kk = e >> 6, nn = e & 63;
            lds[kk * 65 + nn] = (n0 + nn < jb.Nvalid) ? src[(size_t)(k0 + kk) * jb.ld + n0 + nn] : 0.f;
        }
        __syncthreads();
        const int nn = tid >> 3, kk0 = (tid & 7) * 8;
        u32x4v o;
#pragma unroll
        for (int q = 0; q < 4; ++q) o[q] = cvt_pk_bf16(lds[(kk0 + 2 * q) * 65 + nn], lds[(kk0 + 2 * q + 1) * 65 + nn]);
        *(u32x4v*)(W + (size_t)l * W_LAYER + jb.dst + (size_t)(n0 + nn) * jb.K + k0 + kk0) = o;
    }
}
__device__ void phase_prologue(KP p, float* lds, int tid_in) {
    int tid = tid_in; asm volatile("" : "+v"(tid));
    convert_weights(p, lds, tid, 0, 0);
    {
        bf16_t* Xb = (bf16_t*)(p->ws + OFF_XB);
        const size_t n4 = (size_t)M * 1024 / 4, np4 = (size_t)MP * 1024 / 4;
        for (size_t i = (size_t)blockIdx.x * 512 + tid; i < n4; i += (size_t)gridDim.x * 512) {
            const f32x4 v = i < np4 ? ((const f32x4*)p->in[I_XP])[i] : ((const f32x4*)p->in[I_XS])[i - np4];
            u32x2 o; o[0] = cvt_pk_bf16(v[0], v[1]); o[1] = cvt_pk_bf16(v[2], v[3]);
            ((u32x2*)Xb)[i] = o;
        }
    }
    {
        float* rope = (float*)(p->ws + OFF_ROPE);
        for (int i = blockIdx.x * 512 + tid; i < NPOS * 16; i += gridDim.x * 512) {
            const int pos = i >> 4, k = i & 15;
            const float ang = (float)pos * p->inv[k];
            double fr = (double)ang * 0.15915494309189535; fr -= floor(fr);
            rope[pos * 32 + k] = __builtin_amdgcn_cosf((float)fr);
            rope[pos * 32 + 16 + k] = __builtin_amdgcn_sinf((float)fr);
        }
    }
}

__device__ __forceinline__ f32x4 bf4lo(const u32x4v& u) { return (f32x4){bflo(u[0]), bfhi(u[0]), bflo(u[1]), bfhi(u[1])}; }
__device__ __forceinline__ f32x4 bf4hi(const u32x4v& u) { return (f32x4){bflo(u[2]), bfhi(u[2]), bflo(u[3]), bfhi(u[3])}; }
__device__ __forceinline__ f32x4 sig4(const f32x4& v) { return (f32x4){sigmoidf_(v[0]), sigmoidf_(v[1]), sigmoidf_(v[2]), sigmoidf_(v[3])}; }
template <int NTOK, bool SMP>
__device__ __forceinline__ void mix_tile(KP p, int l, float* lds, int tid, int s, int t0) {
    const int wid = tid >> 6, lane = tid & 63;
    unsigned char* big = p->ws + OFF_BIG;
    const bf16_t* P = (const bf16_t*)((const unsigned char*)p->out + D_P);
    bf16_t* QN = (bf16_t*)(big + B_QN); bf16_t* CKV = (bf16_t*)(big + B_CKV); bf16_t* KR = (bf16_t*)(big + B_KR);
    bf16_t* CVN = (bf16_t*)(big + B_CVN); bf16_t* SCZ = (bf16_t*)(big + B_SCZ);
    const float* rope = (const float*)(p->ws + OFF_ROPE);
    float* us = lds;
    float* cvs = lds + 62 * 256;
    constexpr int T = SMP ? DEC_SEQ : SEQ, NR = NTOK + 30, TPW = NTOK / 8, NH = NTOK / 2;
    const int mrow0 = SMP ? MP + s * DEC_SEQ : s * SEQ + t0;
    const int arow0 = SMP ? MP + s * SROW + PAST : s * SEQ + t0;
    const int pos0 = SMP ? PAST : t0;
    float* ckv_out = p->out + (SMP ? OO_CKVS + ((size_t)(l * DEC_BATCH + s) * DEC_SEQ) * 256 : OO_CKVP + ((size_t)(l * BATCH + s) * SEQ + t0) * 256);
    float* kr_out = p->out + (SMP ? OO_KRS + ((size_t)(l * DEC_BATCH + s) * DEC_SEQ) * 32 : OO_KRP + ((size_t)(l * BATCH + s) * SEQ + t0) * 32);
    __syncthreads();
    {
        unsigned xq[TPW][3]; u32x2 xkv[TPW]; float k1[TPW], k2[TPW];
#pragma unroll
        for (int k = 0; k < TPW; ++k) {
            const bf16_t* pr = P + (size_t)(mrow0 + wid + 8 * k) * PW;
#pragma unroll
            for (int j = 0; j < 3; ++j) xq[k][j] = *(const unsigned*)(pr + PC_Q + 2 * lane + 128 * j);
            xkv[k] = *(const u32x2*)(pr + PC_KV + 4 * lane);
            k1[k] = bf2f(pr[PC_KR + (lane & 15)]); k2[k] = bf2f(pr[PC_KR + 16 + (lane & 15)]);
        }
        const float* gq = p->in[I_QNG] + l * Q_LORA;
        float gqv[6];
#pragma unroll
        for (int j = 0; j < 3; ++j) { gqv[2 * j] = gq[2 * lane + 128 * j]; gqv[2 * j + 1] = gq[2 * lane + 128 * j + 1]; }
        const f32x4 gkv = *(const f32x4*)(p->in[I_KVNG] + l * KV_LORA + 4 * lane);
#pragma unroll
        for (int k = 0; k < TPW; ++k) {
            const int i = wid + 8 * k;
            {
                float x[6]; float ss = 0.f;
#pragma unroll
                for (int j = 0; j < 3; ++j) { x[2 * j] = bflo(xq[k][j]); x[2 * j + 1] = bfhi(xq[k][j]); ss += x[2 * j] * x[2 * j] + x[2 * j + 1] * x[2 * j + 1]; }
                ss = wave_sum(ss, lane); const float r = rsqrtf(ss * (1.f / 384.f) + RMS_EPS);
#pragma unroll
                for (int j = 0; j < 3; ++j) *(unsigned*)(QN + (size_t)(mrow0 + i) * 384 + 2 * lane + 128 * j) = cvt_pk_bf16(x[2 * j] * r * gqv[2 * j], x[2 * j + 1] * r * gqv[2 * j + 1]);
            }
            {
                f32x4 x = {bflo(xkv[k][0]), bfhi(xkv[k][0]), bflo(xkv[k][1]), bfhi(xkv[k][1])};
                float ss = x[0] * x[0] + x[1] * x[1] + x[2] * x[2] + x[3] * x[3];
                ss = wave_sum(ss, lane); const float r = rsqrtf(ss * (1.f / 256.f) + RMS_EPS);
                x = x * r * gkv;
                *(f32x4*)(ckv_out + (size_t)i * 256 + 4 * lane) = x;
                u32x2 o; o[0] = cvt_pk_bf16(x[0], x[1]); o[1] = cvt_pk_bf16(x[2], x[3]);
                *(u32x2*)(CKV + (size_t)(arow0 + i) * 256 + 4 * lane) = o;
            }
            if (lane < 16) {
                const float cs = rope[(pos0 + i) * 32 + lane], sn = rope[(pos0 + i) * 32 + 16 + lane];
                const float o1 = k1[k] * cs - k2[k] * sn, o2 = k1[k] * sn + k2[k] * cs;
                kr_out[(size_t)i * 32 + lane] = o1; kr_out[(size_t)i * 32 + 16 + lane] = o2;
                KR[(size_t)(arow0 + i) * 32 + lane] = f2bf(o1); KR[(size_t)(arow0 + i) * 32 + 16 + lane] = f2bf(o2);
            }
        }
    }
    const int cg8 = (tid & 31) * 8, rsub = tid >> 5;
    {
        constexpr int NP = (NR + 15) / 16;
#pragma unroll
        for (int ps = 0; ps < NP; ++ps) {
            const int j = rsub + 16 * ps;
            if (j < NR) {
                const int t = t0 - 30 + j;
                f32x4 u0 = {0.f, 0.f, 0.f, 0.f}, u1 = {0.f, 0.f, 0.f, 0.f};
                if (t >= 0) {
                    const bf16_t* pr = P + (size_t)(mrow0 - t0 + t) * PW;
                    const u32x4v a = *(const u32x4v*)(pr + PC_CA + cg8), g = *(const u32x4v*)(pr + PC_CG + cg8);
                    u0 = bf4lo(a) * sig4(bf4lo(g)); u1 = bf4hi(a) * sig4(bf4hi(g));
                } else if (SMP) {
                    const float* h = p->in[I_SCONF] + ((size_t)(l * DEC_BATCH + s) * 30 + (30 + t)) * 256 + cg8;
                    u0 = *(const f32x4*)h; u1 = *(const f32x4*)(h + 4);
                }
                *(f32x4*)(us + j * 256 + cg8) = u0; *(f32x4*)(us + j * 256 + cg8 + 4) = u1;
            }
        }
    }
    {
        const float* sw = p->in[I_SDW] + (size_t)l * 3 * 256 + cg8;
        const f32x4 w0a = *(const f32x4*)sw, w0b = *(const f32x4*)(sw + 4), w1a = *(const f32x4*)(sw + 256), w1b = *(const f32x4*)(sw + 260), w2a = *(const f32x4*)(sw + 512), w2b = *(const f32x4*)(sw + 516);
        float* so = p->out + (SMP ? OO_SCS + (size_t)(l * DEC_BATCH + s) * 2 * 256 : OO_SCP + (size_t)(l * BATCH + s) * 2 * 256);
#pragma unroll
        for (int ps = 0; ps < NTOK / 16; ++ps) {
            const int i = rsub + 16 * ps, t = t0 + i;
            f32x4 z[3][2];
#pragma unroll
            for (int d = 0; d < 3; ++d) {
                const int tt = t - 2 + d;
                z[d][0] = (f32x4){0.f, 0.f, 0.f, 0.f}; z[d][1] = (f32x4){0.f, 0.f, 0.f, 0.f};
                if (tt >= 0) {
                    const bf16_t* pr = P + (size_t)(mrow0 - t0 + tt) * PW;
                    const u32x4v gc = *(const u32x4v*)(pr + PC_GC + cg8), hh = *(const u32x4v*)(pr + PC_H + cg8);
                    z[d][0] = bf4lo(gc) * bf4lo(hh); z[d][1] = bf4hi(gc) * bf4hi(hh);
                } else if (SMP) {
                    const float* hs = p->in[I_SSC] + ((size_t)(l * DEC_BATCH + s) * 2 + (2 + tt)) * 256 + cg8;
                    z[d][0] = *(const f32x4*)hs; z[d][1] = *(const f32x4*)(hs + 4);
                }
            }
            const u32x4v gb = *(const u32x4v*)(P + (size_t)(mrow0 + i) * PW + PC_GB + cg8);
            const f32x4 c0 = (w0a * z[0][0] + w1a * z[1][0] + w2a * z[2][0]) * bf4lo(gb), c1 = (w0b * z[0][1] + w1b * z[1][1] + w2b * z[2][1]) * bf4hi(gb);
            u32x4v o; o[0] = cvt_pk_bf16(c0[0], c0[1]); o[1] = cvt_pk_bf16(c0[2], c0[3]); o[2] = cvt_pk_bf16(c1[0], c1[1]); o[3] = cvt_pk_bf16(c1[2], c1[3]);
            *(u32x4v*)(SCZ + (size_t)(mrow0 + i) * 256 + cg8) = o;
            if (t >= T - 2) { float* sp = so + (t - (T - 2)) * 256 + cg8; *(f32x4*)sp = z[2][0]; *(f32x4*)(sp + 4) = z[2][1]; }
        }
    }
    __syncthreads();
    {
        const int c = tid & 255, half = tid >> 8, i0 = half * NH;
        float w[31];
#pragma unroll
        for (int k = 0; k < 31; ++k) w[k] = p->in[I_CDW][((size_t)l * 31 + k) * 256 + c];
        const float b = p->in[I_CDB][l * 256 + c];
        float ur[NH + 30];
#pragma unroll
        for (int k = 0; k < NH + 30; ++k) ur[k] = us[(i0 + k) * 256 + c];
#pragma unroll
        for (int i = 0; i < NH; ++i) {
            float a = b;
#pragma unroll
            for (int k = 0; k < 31; ++k) a += w[k] * ur[i + k];
            cvs[(i0 + i) * 256 + c] = a;
        }
        if (t0 + NTOK == T) {
            float* co = p->out + (SMP ? OO_CONFS + (size_t)(l * DEC_BATCH + s) * 30 * 256 : OO_CONFP + (size_t)(l * BATCH + s) * 30 * 256);
            for (int j = half; j < 30; j += 2) co[j * 256 + c] = us[(NTOK + j) * 256 + c];
        }
    }
    __syncthreads();
    {
        const f32x4 g = *(const f32x4*)(p->in[I_CLG] + l * 256 + 4 * lane), bb = *(const f32x4*)(p->in[I_CLB] + l * 256 + 4 * lane);
#pragma unroll
        for (int k = 0; k < TPW; ++k) {
            const int i = wid + 8 * k;
            const f32x4 x = *(const f32x4*)(cvs + i * 256 + 4 * lane);
            const float mu = wave_sum(x[0] + x[1] + x[2] + x[3], lane) * (1.f / 256.f);
            const f32x4 d = x - mu;
            const float var = wave_sum(d[0] * d[0] + d[1] * d[1] + d[2] * d[2] + d[3] * d[3], lane) * (1.f / 256.f);
            const float r = rsqrtf(var + LN_EPS);
            f32x4 y = d * r * g + bb;
#pragma unroll
            for (int j = 0; j < 4; ++j) y[j] = y[j] * sigmoidf_(y[j]);
            u32x2 o; o[0] = cvt_pk_bf16(y[0], y[1]); o[1] = cvt_pk_bf16(y[2], y[3]);
            *(u32x2*)(CVN + (size_t)(mrow0 + i) * 256 + 4 * lane) = o;
        }
    }
}

__device__ void phase_mixprep(KP p, int l, float* lds, int tid_in) {
    int tid_ = tid_in; asm volatile("" : "+v"(tid_));
    const int tid = tid_;
    unsigned char* big = p->ws + OFF_BIG;
    bf16_t* CKV = (bf16_t*)(big + B_CKV); bf16_t* KR = (bf16_t*)(big + B_KR);
    for (int it = blockIdx.x; it < 2576; it += gridDim.x) {
        if (it >= 2064) {
            const int c = it - 2064, s = c >> 5, r0 = (c & 31) * 64;
            const float* src = p->in[I_CCKV] + ((size_t)(l * DEC_BATCH + s) * PAST + r0) * 256;
            bf16_t* dst = CKV + (size_t)(MP + s * SROW + r0) * 256;
#pragma unroll
            for (int i = 0; i < 8; ++i) { const int e = tid + i * 512; const f32x4 v = ((const f32x4*)src)[e]; u32x2 o; o[0] = cvt_pk_bf16(v[0], v[1]); o[1] = cvt_pk_bf16(v[2], v[3]); ((u32x2*)dst)[e] = o; }
            const float* src2 = p->in[I_CKR] + ((size_t)(l * DEC_BATCH + s) * PAST + r0) * 32;
            bf16_t* dst2 = KR + (size_t)(MP + s * SROW + r0) * 32;
            { const f32x4 v = ((const f32x4*)src2)[tid]; u32x2 o; o[0] = cvt_pk_bf16(v[0], v[1]); o[1] = cvt_pk_bf16(v[2], v[3]); ((u32x2*)dst2)[tid] = o; }
            if ((c & 31) == 0) {
                bf16_t* z = CKV + (size_t)(MP + s * SROW + PAST + DEC_SEQ) * 256;
                for (int e = tid; e < 48 * 256 / 2; e += 512) ((unsigned*)z)[e] = 0u;
                bf16_t* z2 = KR + (size_t)(MP + s * SROW + PAST + DEC_SEQ) * 32;
                for (int e = tid; e < 48 * 32 / 2; e += 512) ((unsigned*)z2)[e] = 0u;
            }
        } else if (it >= 2048) mix_tile<16, true>(p, l, lds, tid, it - 2048, 0);
        else mix_tile<32, false>(p, l, lds, tid, it >> 6, (it & 63) * 32);
    }
}

template <int NQB>
__device__ __forceinline__ void attn_wave(const bf16_t* __restrict__ Q, const bf16_t* __restrict__ KN, const bf16_t* __restrict__ KRp, const bf16_t* __restrict__ VT,
                                          int kt0, int kstep, int ntiles, int nkeys, float* part, int lane) {
    const int fr = lane & 15, g = lane >> 4;
    bf16x8 qf[3][NQB];
#pragma unroll
    for (int ks = 0; ks < 3; ++ks)
#pragma unroll
        for (int nb = 0; nb < NQB; ++nb) qf[ks][nb] = *(const bf16x8*)(Q + (size_t)(nb * 16 + fr) * 768 + ks * 32 + g * 8);
    f32x4 o[4][NQB]; float mrun[NQB], lrun[NQB];
#pragma unroll
    for (int nb = 0; nb < NQB; ++nb) { mrun[nb] = -1e30f; lrun[nb] = 0.f;
#pragma unroll
        for (int df = 0; df < 4; ++df) o[df][nb] = (f32x4){0.f, 0.f, 0.f, 0.f}; }
    bf16x8 kc[4][3], kx[4][3];
#define ATT_LOADK(dst, kt_) do { const bf16_t* kn_ = KN + (size_t)(kt_) * 64 * 512; const bf16_t* kr_ = KRp + (size_t)(kt_) * 64 * 32; \
        _Pragma("unroll") for (int f = 0; f < 4; ++f) { dst[f][0] = *(const bf16x8*)(kn_ + (size_t)(f * 16 + fr) * 512 + g * 8); \
            dst[f][1] = *(const bf16x8*)(kn_ + (size_t)(f * 16 + fr) * 512 + 32 + g * 8); dst[f][2] = *(const bf16x8*)(kr_ + (size_t)(f * 16 + fr) * 32 + g * 8); } } while (0)
    ATT_LOADK(kc, kt0);
    for (int kt = kt0; kt < ntiles; kt += kstep) {
        const bf16_t* vt = VT + kt * 64;
        u32x2 vv[4][2][2];
#pragma unroll
        for (int df = 0; df < 4; ++df)
#pragma unroll
            for (int kk = 0; kk < 2; ++kk) { const bf16_t* vrow = vt + (size_t)(df * 16 + fr) * MA;
                vv[df][kk][0] = *(const u32x2*)(vrow + (2 * kk) * 16 + g * 4); vv[df][kk][1] = *(const u32x2*)(vrow + (2 * kk + 1) * 16 + g * 4); }
        { const int kn1 = (kt + kstep < ntiles) ? kt + kstep : kt; ATT_LOADK(kx, kn1); }
        f32x4 st[4][NQB];
#pragma unroll
        for (int f = 0; f < 4; ++f) {
#pragma unroll
            for (int nb = 0; nb < NQB; ++nb) {
                f32x4 c = {0.f, 0.f, 0.f, 0.f};
                c = __builtin_amdgcn_mfma_f32_16x16x32_bf16(kc[f][0], qf[0][nb], c, 0, 0, 0);
                c = __builtin_amdgcn_mfma_f32_16x16x32_bf16(kc[f][1], qf[1][nb], c, 0, 0, 0);
                c = __builtin_amdgcn_mfma_f32_16x16x32_bf16(kc[f][2], qf[2][nb], c, 0, 0, 0);
                st[f][nb] = c;
            }
        }
        if ((kt + 1) * 64 > nkeys) {
#pragma unroll
            for (int f = 0; f < 4; ++f)
#pragma unroll
                for (int r = 0; r < 4; ++r) if (kt * 64 + f * 16 + g * 4 + r >= nkeys) {
#pragma unroll
                    for (int nb = 0; nb < NQB; ++nb) st[f][nb][r] = -1e30f; }
        }
#pragma unroll
        for (int nb = 0; nb < NQB; ++nb) {
            float mx = -1e30f;
#pragma unroll
            for (int f = 0; f < 4; ++f)
#pragma unroll
                for (int r = 0; r < 4; ++r) mx = fmaxf(mx, st[f][nb][r]);
            mx = fmaxf(mx, shx(mx, 16, lane)); mx = fmaxf(mx, shx(mx, 32, lane));
            const float mn = fmaxf(mrun[nb], mx), al = __builtin_amdgcn_exp2f(mrun[nb] - mn); mrun[nb] = mn;
            float ps = 0.f;
#pragma unroll
            for (int f = 0; f < 4; ++f)
#pragma unroll
                for (int r = 0; r < 4; ++r) { const float e = __builtin_amdgcn_exp2f(st[f][nb][r] - mn); st[f][nb][r] = e; ps += e; }
            lrun[nb] = lrun[nb] * al + ps;
#pragma unroll
            for (int df = 0; df < 4; ++df) o[df][nb] *= al;
        }
#pragma unroll
        for (int kk = 0; kk < 2; ++kk) {
            bf16x8 pb[NQB];
#pragma unroll
            for (int nb = 0; nb < NQB; ++nb) {
                u32x4v t; t[0] = cvt_pk_bf16(st[2 * kk][nb][0], st[2 * kk][nb][1]); t[1] = cvt_pk_bf16(st[2 * kk][nb][2], st[2 * kk][nb][3]);
                t[2] = cvt_pk_bf16(st[2 * kk + 1][nb][0], st[2 * kk + 1][nb][1]); t[3] = cvt_pk_bf16(st[2 * kk + 1][nb][2], st[2 * kk + 1][nb][3]);
                pb[nb] = __builtin_bit_cast(bf16x8, t);
            }
#pragma unroll
            for (int df = 0; df < 4; ++df) {
                u32x4v t; const u32x2 v0 = vv[df][kk][0], v1 = vv[df][kk][1];
                t[0] = v0[0]; t[1] = v0[1]; t[2] = v1[0]; t[3] = v1[1];
                const bf16x8 a = __builtin_bit_cast(bf16x8, t);
#pragma unroll
                for (int nb = 0; nb < NQB; ++nb) o[df][nb] = __builtin_amdgcn_mfma_f32_16x16x32_bf16(a, pb[nb], o[df][nb], 0, 0, 0);
            }
        }
#pragma unroll
        for (int f = 0; f < 4; ++f)
#pragma unroll
            for (int k3 = 0; k3 < 3; ++k3) kc[f][k3] = kx[f][k3];
    }
#undef ATT_LOADK
    {
        float ls = lrun[0]; ls += shx(ls, 16, lane); ls += shx(ls, 32, lane);
#pragma unroll
        for (int df = 0; df < 4; ++df)
#pragma unroll
            for (int r = 0; r < 4; ++r) part[(df * 16 + g * 4 + r) * 16 + fr] = o[df][0][r];
        if (g == 0) { part[1024 + fr] = mrun[0]; part[1040 + fr] = ls; }
    }
}

__device__ void phase_attn(KP p, PG8_LAS unsigned char* lds, float* ldsf, int tid_in) {
    int tid_ = tid_in; asm volatile("" : "+v"(tid_));
    const int tid = tid_, wid = tid >> 6, lane = tid & 63, fr = lane & 15, g = lane >> 4;
    unsigned char* big = p->ws + OFF_BIG;
    const bf16_t* Q = (const bf16_t*)((const unsigned char*)p->out + D_Q); const bf16_t* KN = (const bf16_t*)((const unsigned char*)p->out + D_KN); const bf16_t* KR = (const bf16_t*)(big + B_KR);
    const bf16_t* VT = (const bf16_t*)(p->ws + OFF_VT); bf16_t* O = (bf16_t*)(big + B_O);
    for (int j = blockIdx.x; j < DEC_BATCH * N_HEADS; j += gridDim.x) {
        const int s = j >> 3, h = j & 7; const size_t kr0 = (size_t)MP + (size_t)s * SROW, qr0 = (size_t)MP + (size_t)s * DEC_SEQ;
        __syncthreads();
        attn_wave<1>(Q + qr0 * 768 + h * 96, KN + kr0 * 512 + h * 64, KR + kr0 * 32, VT + (size_t)(h * 64) * MA + kr0, wid, 8, 33, NPOS, ldsf + wid * 1056, lane);
        __syncthreads();
        for (int e = tid; e < 1024; e += 512) {
            const int d = e >> 4, q = e & 15;
            float mm = -1e30f;
#pragma unroll
            for (int w = 0; w < 8; ++w) mm = fmaxf(mm, ldsf[w * 1056 + 1024 + q]);
            float L = 0.f, Os = 0.f;
#pragma unroll
            for (int w = 0; w < 8; ++w) { const float sc = __builtin_amdgcn_exp2f(ldsf[w * 1056 + 1024 + q] - mm); L += ldsf[w * 1056 + 1040 + q] * sc; Os += ldsf[w * 1056 + e] * sc; }
            O[(qr0 + q) * 512 + h * 64 + d] = f2bf(Os / L);
        }
        __syncthreads();
    }
    constexpr int KS = 104, VS = 72, KB = 64 * KS * 2, VB = 64 * VS * 2, BUF = KB + VB;
    const bool lo = tid < 256;
    const int krow = tid >> 3, kch = (tid & 7) * 8;
    const int rrow = (tid & 255) >> 2, rch = (tid & 3) * 8;
    const int vdA = lo ? 32 + (tid >> 3) : (tid - 256) >> 3;
    const unsigned k_st = (unsigned)(krow * KS + kch) * 2u, r_st = (unsigned)(rrow * KS + 64 + rch) * 2u, v_st = (unsigned)KB + (unsigned)(vdA * VS + kch) * 2u;
    const unsigned ka_rd = (unsigned)(fr * KS + g * 8) * 2u, va_rd = (unsigned)KB + (unsigned)(fr * VS + g * 4) * 2u;
    for (int bh = blockIdx.x; bh < BATCH * N_HEADS; bh += gridDim.x) {
        const int b = bh >> 3, h = bh & 7; const size_t kr0 = (size_t)b * SEQ;
        const bf16_t* KNb = KN + kr0 * 512 + h * 64 + (size_t)krow * 512 + kch;
        const bf16_t* KRb = KR + kr0 * 32 + (size_t)rrow * 32 + rch;
        const bf16_t* VTb = VT + (size_t)(h * 64 + vdA) * MA + kr0 + kch;
        for (int qb = 7; qb >= 0; --qb) {
            const int qw = qb * 8 + (7 - wid), cw = qw >> 1, nt = 4 * qb + 4;
            const bf16_t* Qw = Q + (kr0 + (size_t)qw * 32) * 768 + h * 96;
            bf16x8 qf[3][2];
#pragma unroll
            for (int ks = 0; ks < 3; ++ks)
#pragma unroll
                for (int nb = 0; nb < 2; ++nb) qf[ks][nb] = *(const bf16x8*)(Qw + (size_t)(nb * 16 + fr) * 768 + ks * 32 + g * 8);
            f32x4 o[4][2]; float mrun[2], lrun[2];
#pragma unroll
            for (int nb = 0; nb < 2; ++nb) { mrun[nb] = -1e30f; lrun[nb] = 0.f;
#pragma unroll
                for (int df = 0; df < 4; ++df) o[df][nb] = (f32x4){0.f, 0.f, 0.f, 0.f}; }
            u32x4v r0, r1, r2;
#define AT_GLOAD(kt_) do { r0 = *(const u32x4v*)(KNb + (size_t)(kt_) * 64 * 512); \
                if (lo) { r1 = *(const u32x4v*)(KRb + (size_t)(kt_) * 64 * 32); r2 = *(const u32x4v*)(VTb + (kt_) * 64); } \
                else { r1 = *(const u32x4v*)(VTb + (kt_) * 64); } } while (0)
#define AT_LSTORE(bf_) do { PG8_LAS unsigned char* bb_ = lds + (bf_) * BUF; *(PG8_LAS u32x4v*)(bb_ + k_st) = r0; \
                if (lo) { *(PG8_LAS u32x4v*)(bb_ + r_st) = r1; *(PG8_LAS u32x4v*)(bb_ + v_st) = r2; } else { *(PG8_LAS u32x4v*)(bb_ + v_st) = r1; } } while (0)
            AT_GLOAD(0); AT_LSTORE(0); __syncthreads();
            for (int kt = 0; kt < nt; ++kt) {
                if (kt + 1 < nt) AT_GLOAD(kt + 1);
                if (kt <= cw) {
                    const PG8_LAS unsigned char* kb = lds + (kt & 1) * BUF;
                    f32x4 st[4][2];
#pragma unroll
                    for (int f = 0; f < 4; ++f) {
                        const bf16x8 a0 = *(const PG8_LAS bf16x8*)(kb + ka_rd + f * 16 * KS * 2);
                        const bf16x8 a1 = *(const PG8_LAS bf16x8*)(kb + ka_rd + f * 16 * KS * 2 + 64);
                        const bf16x8 a2 = *(const PG8_LAS bf16x8*)(kb + ka_rd + f * 16 * KS * 2 + 128);
#pragma unroll
                        for (int nb = 0; nb < 2; ++nb) {
                            f32x4 c = {0.f, 0.f, 0.f, 0.f};
                            c = __builtin_amdgcn_mfma_f32_16x16x32_bf16(a0, qf[0][nb], c, 0, 0, 0);
                            c = __builtin_amdgcn_mfma_f32_16x16x32_bf16(a1, qf[1][nb], c, 0, 0, 0);
                            c = __builtin_amdgcn_mfma_f32_16x16x32_bf16(a2, qf[2][nb], c, 0, 0, 0);
                            st[f][nb] = c;
                        }
                    }
#pragma unroll
                    for (int nb = 0; nb < 2; ++nb) {
                        float mx = -1e30f;
#pragma unroll
                        for (int f = 0; f < 4; ++f)
#pragma unroll
                            for (int r = 0; r < 4; ++r) mx = fmaxf(mx, st[f][nb][r]);
                        mx = fmaxf(mx, shx(mx, 16, lane)); mx = fmaxf(mx, shx(mx, 32, lane));
                        const float mn = fmaxf(mrun[nb], mx), al = __builtin_amdgcn_exp2f(mrun[nb] - mn); mrun[nb] = mn;
                        float ps = 0.f;
#pragma unroll
                        for (int f = 0; f < 4; ++f)
#pragma unroll
                            for (int r = 0; r < 4; ++r) { const float e = __builtin_amdgcn_exp2f(st[f][nb][r] - mn); st[f][nb][r] = e; ps += e; }
                        lrun[nb] = lrun[nb] * al + ps;
#pragma unroll
                        for (int df = 0; df < 4; ++df) o[df][nb] *= al;
                    }
#pragma unroll
                    for (int kk = 0; kk < 2; ++kk) {
                        bf16x8 pb[2];
#pragma unroll
                        for (int nb = 0; nb < 2; ++nb) {
                            u32x4v t; t[0] = cvt_pk_bf16(st[2 * kk][nb][0], st[2 * kk][nb][1]); t[1] = cvt_pk_bf16(st[2 * kk][nb][2], st[2 * kk][nb][3]);
                            t[2] = cvt_pk_bf16(st[2 * kk + 1][nb][0], st[2 * kk + 1][nb][1]); t[3] = cvt_pk_bf16(st[2 * kk + 1][nb][2], st[2 * kk + 1][nb][3]);
                            pb[nb] = __builtin_bit_cast(bf16x8, t);
                        }
#pragma unroll
                        for (int df = 0; df < 4; ++df) {
                            const u32x2 v0 = *(const PG8_LAS u32x2*)(kb + va_rd + df * 16 * VS * 2 + kk * 64), v1 = *(const PG8_LAS u32x2*)(kb + va_rd + df * 16 * VS * 2 + kk * 64 + 32);
                            u32x4v t; t[0] = v0[0]; t[1] = v0[1]; t[2] = v1[0]; t[3] = v1[1];
                            const bf16x8 a = __builtin_bit_cast(bf16x8, t);
#pragma unroll
                            for (int nb = 0; nb < 2; ++nb) o[df][nb] = __builtin_amdgcn_mfma_f32_16x16x32_bf16(a, pb[nb], o[df][nb], 0, 0, 0);
                        }
                    }
                }
                if (kt + 1 < nt) AT_LSTORE((kt + 1) & 1);
                __syncthreads();
            }
#undef AT_GLOAD
#undef AT_LSTORE
            bf16_t* Ow = O + (kr0 + (size_t)qw * 32) * 512 + h * 64;
#pragma unroll
            for (int nb = 0; nb < 2; ++nb) {
                float ls = lrun[nb]; ls += shx(ls, 16, lane); ls += shx(ls, 32, lane);
                const float inv = 1.f / ls;
#pragma unroll
                for (int df = 0; df < 4; ++df) {
                    u32x2 t; t[0] = cvt_pk_bf16(o[df][nb][0] * inv, o[df][nb][1] * inv); t[1] = cvt_pk_bf16(o[df][nb][2] * inv, o[df][nb][3] * inv);
                    *(u32x2*)(Ow + (size_t)(nb * 16 + fr) * 512 + df * 16 + g * 4) = t;
                }
            }
        }
    }
}

__device__ void phase_ln(KP p, const float* g, const float* b, bool final_out, int tid_in, int r0, int r1, int b0) {
    if ((int)blockIdx.x < b0) return;
    int tid_ = tid_in; asm volatile("" : "+v"(tid_));
    const int lane = tid_ & 63, gw = ((int)blockIdx.x - b0) * 8 + (tid_ >> 6), nw = ((int)gridDim.x - b0) * 8;
    bf16_t* Xb = (bf16_t*)(p->ws + OFF_XB);
    f32x4 gv[4], bv[4];
#pragma unroll
    for (int j = 0; j < 2; ++j)
#pragma unroll
        for (int q = 0; q < 2; ++q) { gv[2 * j + q] = *(const f32x4*)(g + lane * 8 + 512 * j + 4 * q); bv[2 * j + q] = *(const f32x4*)(b + lane * 8 + 512 * j + 4 * q); }
    for (int row = r0 + gw; row < r1; row += nw) {
        bf16_t* xr = Xb + (size_t)row * 1024 + lane * 8;
        f32x4 x[4]; float s = 0.f;
#pragma unroll
        for (int j = 0; j < 2; ++j) { const u32x4v u = *(const u32x4v*)(xr + 512 * j);
            x[2 * j] = (f32x4){bflo(u[0]), bfhi(u[0]), bflo(u[1]), bfhi(u[1])}; x[2 * j + 1] = (f32x4){bflo(u[2]), bfhi(u[2]), bflo(u[3]), bfhi(u[3])}; }
#pragma unroll
        for (int j = 0; j < 4; ++j) s += x[j][0] + x[j][1] + x[j][2] + x[j][3];
        const float mu = wave_sum(s, lane) * (1.f / 1024.f); float v = 0.f;
#pragma unroll
        for (int j = 0; j < 4; ++j) { x[j] = x[j] - mu; v += x[j][0] * x[j][0] + x[j][1] * x[j][1] + x[j][2] * x[j][2] + x[j][3] * x[j][3]; }
        const float r = rsqrtf(wave_sum(v, lane) * (1.f / 1024.f) + LN_EPS);
#pragma unroll
        for (int j = 0; j < 2; ++j) {
            const f32x4 y0 = x[2 * j] * r * gv[2 * j] + bv[2 * j], y1 = x[2 * j + 1] * r * gv[2 * j + 1] + bv[2 * j + 1];
            if (final_out) { float* yo = p->out + (size_t)row * 1024 + lane * 8 + 512 * j; *(f32x4*)yo = y0; *(f32x4*)(yo + 4) = y1; }
            else { u32x4v o; o[0] = cvt_pk_bf16(y0[0], y0[1]); o[1] = cvt_pk_bf16(y0[2], y0[3]); o[2] = cvt_pk_bf16(y1[0], y1[1]); o[3] = cvt_pk_bf16(y1[2], y1[3]);
                *(u32x4v*)(xr + 512 * j) = o; }
        }
    }
}
constexpr size_t OFF_BAR = WS_END;

#define XB_TMO      128
#define XB_XCNT(j)  (256  + 64 * (j))
#define XB_XSUB(j)  (1280 + 64 * (j))
#define XB_XGEN(j)  (2304 + 64 * (j))
#define XB_TOP      3328
#define XB_TOPGEN   3392
#define XCD_BAR_WORDS 3456
#define XB_SPIN_CAP (1u << 18)
__device__ __forceinline__ unsigned xb_ld(unsigned* p)              { return __hip_atomic_load(p, __ATOMIC_RELAXED, __HIP_MEMORY_SCOPE_AGENT); }
__device__ __forceinline__ unsigned xb_add(unsigned* p, unsigned v) { return __hip_atomic_fetch_add(p, v, __ATOMIC_RELAXED, __HIP_MEMORY_SCOPE_AGENT); }
__device__ __forceinline__ unsigned xb_xcc_id() { return (unsigned)__builtin_amdgcn_s_getreg((3 << 11) | 20) & 0xFu; }
#define XB_SPIN(cond, bar) do { unsigned _sp = 0; while (cond) { __builtin_amdgcn_s_sleep(1); \
    if ((++_sp & 255u) == 0u) { if (xb_ld(&(bar)[XB_TMO])) break; if (_sp > XB_SPIN_CAP) { atomicAdd(&(bar)[XB_TMO], 1u); break; } } } } while (0)
__device__ __forceinline__ void xcd_barrier_complete(unsigned* bar, unsigned x, unsigned& nloc, unsigned& nx) {
    const unsigned G = gridDim.x;
    unsigned sum, cnt, mine, sp = 0u;
    for (;;) {
        sum = 0u; cnt = 0u; mine = 0u;
#pragma unroll
        for (unsigned j = 0; j < 16; ++j) { const unsigned c = xb_ld(&bar[XB_XCNT(j)]); sum += c; cnt += (c > 0u) ? 1u : 0u; mine = (j == x) ? c : mine; }
        if (sum == G) break;
        __builtin_amdgcn_s_sleep(1);
        if ((++sp & 255u) == 0u) { if (xb_ld(&bar[XB_TMO])) break; if (sp > XB_SPIN_CAP) { atomicAdd(&bar[XB_TMO], 1u); break; } }
    }
    nloc = mine > 0u ? mine : 1u; nx = cnt > 0u ? cnt : 1u;
}
__device__ __forceinline__ void xcd_barrier(unsigned* bar, unsigned x, volatile PG8_LAS unsigned* st, int tid) {
    asm volatile("s_waitcnt vmcnt(0)" ::: "memory");
    __syncthreads();
    if (tid == 0) {
        __builtin_amdgcn_s_waitcnt(0);
        unsigned nloc = st[0], nx = st[1];
        if (nloc == 0u) { xcd_barrier_complete(bar, x, nloc, nx); st[0] = nloc; st[1] = nx; }
        const unsigned old = xb_add(&bar[XB_XSUB(x)], 1u);
        const unsigned gen = old / nloc;
        if (old + 1u == (gen + 1u) * nloc) {
            __builtin_amdgcn_fence(__ATOMIC_RELEASE, "agent");
            asm volatile("s_waitcnt vmcnt(0)" ::: "memory");
            const unsigned og = xb_add(&bar[XB_TOP], 1u);
            const unsigned tg = og / nx;
            if (og + 1u == (tg + 1u) * nx) xb_add(&bar[XB_TOPGEN], 1u);
            else XB_SPIN(xb_ld(&bar[XB_TOPGEN]) == tg, bar);
            __builtin_amdgcn_fence(__ATOMIC_ACQUIRE, "agent");
            xb_add(&bar[XB_XGEN(x)], 1u);
            asm volatile("s_waitcnt vmcnt(0)" ::: "memory");
        } else {
            XB_SPIN(xb_ld(&bar[XB_XGEN(x)]) == gen, bar);
            __builtin_amdgcn_fence(__ATOMIC_ACQUIRE, "agent");
            asm volatile("s_waitcnt vmcnt(0)" ::: "memory");
        }
    }
    __syncthreads();
}
__global__ void __launch_bounds__(512, 2) fwd_megakernel(Params p_unused) {
    extern __shared__ __attribute__((aligned(16))) unsigned char shm[];
    PG8_LAS unsigned char* lds = (PG8_LAS unsigned char*)shm;
    float* ldsf = (float*)shm;
    cg::grid_group grid = cg::this_grid();
    KP p = (KP)__builtin_amdgcn_kernarg_segment_ptr();
    const int wid_s = __builtin_amdgcn_readfirstlane((int)threadIdx.x >> 6);
    grid.sync();
    {
        volatile PG8_LAS unsigned* xst = (volatile PG8_LAS unsigned*)(lds + pg8::STAGE_BYTES);
        if (threadIdx.x == 0) { xst[0] = 0u; xst[1] = 0u; (void)xb_add(&((unsigned*)(p->ws + OFF_BAR))[XB_XCNT(xb_xcc_id())], 1u); }
        __syncthreads();
    }
#define TID() (wid_s * 64 + lane_id_v())
#define GSYNC() xcd_barrier((unsigned*)(p->ws + OFF_BAR), xb_xcc_id(), (volatile PG8_LAS unsigned*)(lds + pg8::STAGE_BYTES), TID())
    unsigned char* big = p->ws + OFF_BIG;
    unsigned char* dsc = (unsigned char*)p->out;
    bf16_t* Xb = (bf16_t*)(p->ws + OFF_XB);
    const float* rope = (const float*)(p->ws + OFF_ROPE);
    phase_prologue(p, ldsf, TID());
    GSYNC();
#pragma unroll 1
    for (int l = 0; l < DEPTH; ++l) {
        const bf16_t* W = (const bf16_t*)(p->ws + OFF_W) + (size_t)l * W_LAYER;
        { EpiPG e; e.P = (bf16_t*)(dsc + D_P); e.G3 = (bf16_t*)(big + B_G3); e.bias = p->in[I_BGATE] + (size_t)l * 3 * 1024; run_gemm(lds, TID(), Xb, W + WO_A, M, 5120, 1024, e); }
        GSYNC();
        phase_mixprep(p, l, ldsf, TID());
        GSYNC();
        { EpiQ e; e.O = (bf16_t*)(dsc + D_Q); e.rope = rope; run_gemm(lds, TID(), (const bf16_t*)(big + B_QN), W + WO_UQ, M, 768, 384, e); }
        { EpiB<0> e; e.O = (bf16_t*)(dsc + D_KN); e.ldc = 512; e.bias = nullptr; e.G = nullptr; e.ldg = 0; run_gemm(lds, TID(), (const bf16_t*)(big + B_CKV), W + WO_UK, MA, 512, 256, e); }
        { EpiB<0> e; e.O = (bf16_t*)(p->ws + OFF_VT); e.ldc = MA; e.bias = nullptr; e.G = nullptr; e.ldg = 0; run_gemm(lds, TID(), W + WO_UV, (const bf16_t*)(big + B_CKV), 512, MA, 256, e); }
        GSYNC();
        phase_attn(p, lds, ldsf, TID());
        GSYNC();
        {
            const bf16_t* G3 = (const bf16_t*)(big + B_G3); bf16_t* MG = (bf16_t*)(dsc + D_MG);
            { EpiB<3> e; e.O = MG; e.ldc = 1024; e.bias = nullptr; e.G = G3; e.ldg = 3072; run_gemm(lds, TID(), (const bf16_t*)(big + B_O), W + WO_MLA, M, 1024, 512, e); }
            { EpiB<4> e; e.O = MG; e.ldc = 1024; e.bias = nullptr; e.G = G3 + 1024; e.ldg = 3072; run_gemm(lds, TID(), (const bf16_t*)(big + B_CVN), W + WO_CONF, M, 1024, 256, e); }
            { EpiB<4> e; e.O = MG; e.ldc = 1024; e.bias = nullptr; e.G = G3 + 2048; e.ldg = 3072; run_gemm(lds, TID(), (const bf16_t*)(big + B_SCZ), W + WO_SC, M, 1024, 256, e); }
        }
        GSYNC();
#pragma unroll 1
        for (int part = 0; part < 2; ++part) {
            EpiB<5> e; e.O = part ? Xb + (size_t)MP * 1024 : Xb; e.ldc = 1024; e.bias = nullptr; e.G = nullptr; e.ldg = 0;
            run_gemm(lds, TID(), (const bf16_t*)(dsc + D_MG) + (part ? (size_t)MP * 1024 : 0), W + WO_MIX, part ? MS : MP, 1024, 1024, e);
            if (part == 0) GSYNC();
        }
#pragma unroll 1
        for (int part = 0; part < 2; ++part) {
            phase_ln(p, p->in[I_LN1G] + l * 1024, p->in[I_LN1B] + l * 1024, false, TID(), part ? MP : 0, part ? M : MP, part ? 0 : 4);
            GSYNC();
        }
        { EpiB<1> e; e.O = (bf16_t*)big; e.ldc = 4096; e.bias = p->in[I_BFF1] + (size_t)l * 4096; e.G = nullptr; e.ldg = 0; run_gemm(lds, TID(), Xb, W + WO_FF1, M, 4096, 1024, e); }
        GSYNC();
#pragma unroll 1
        for (int part = 0; part < 2; ++part) {
            EpiB<5> e; e.O = part ? Xb + (size_t)MP * 1024 : Xb; e.ldc = 1024; e.bias = p->in[I_BFF2] + l * 1024; e.G = nullptr; e.ldg = 0;
            run_gemm(lds, TID(), (const bf16_t*)big + (part ? (size_t)MP * 4096 : 0), W + WO_FF2, part ? MS : MP, 1024, 4096, e);
            if (part == 0) GSYNC();
        }
#pragma unroll 1
        for (int part = 0; part < 2; ++part) {
            phase_ln(p, p->in[I_LN2G] + l * 1024, p->in[I_LN2B] + l * 1024, l == DEPTH - 1, TID(), part ? MP : 0, part ? M : MP, part ? 0 : 4);
            if (part == 0 && l + 1 < DEPTH) convert_weights(p, ldsf, TID(), l + 1, 4);
            GSYNC();
        }
    }
}

extern "C" void kernel_launch(void* const* d_in, const int* in_sizes, int n_in, void* d_out, int out_size, void* d_ws, size_t ws_size, hipStream_t stream) {
    constexpr size_t kDynLds = pg8::STAGE_BYTES + 64;
    static int grid_blocks = 0;
    if (!grid_blocks) {
        hipFuncSetAttribute((const void*)fwd_megakernel, hipFuncAttributeMaxDynamicSharedMemorySize, (int)kDynLds);
        int dev = 0, cus = 0, per_cu = 0;
        hipGetDevice(&dev);
        hipDeviceGetAttribute(&cus, hipDeviceAttributeMultiprocessorCount, dev);
        hipOccupancyMaxActiveBlocksPerMultiprocessor(&per_cu, fwd_megakernel, 512, kDynLds);
        if (per_cu < 1) per_cu = 1;
        grid_blocks = cus * (per_cu > 1 ? 1 : per_cu);
    }
    if (ws_size < OFF_BAR + 16384) { fprintf(stderr, "workspace too small: %zu < %zu\n", ws_size, (size_t)WS_END); return; }
    Params p; memset(&p, 0, sizeof(p));
    for (int i = 0; i < 30; ++i) p.in[i] = (const float*)d_in[i];
    p.out = (float*)d_out; p.ws = (unsigned char*)d_ws;
    for (int i = 0; i < 16; ++i) p.inv[i] = powf(10000.0f, -(float)i / 16.0f);
    (void)hipMemsetAsync((unsigned char*)d_ws + OFF_BAR, 0, XCD_BAR_WORDS * 4, stream);
    void* args[] = {&p};
    hipError_t e = hipLaunchCooperativeKernel((const void*)fwd_megakernel, dim3(grid_blocks), dim3(512), args, kDynLds, stream);
    if (e != hipSuccess) fprintf(stderr, "cooperative launch failed: %s (grid %d)\n", hipGetErrorString(e), grid_blocks);
}
```
